# Optimizing an MI355X kernel written in HIP

```python
import jax, jax.numpy as jnp
from jax import lax
import numpy as np

D_MODEL = 1024
BATCH = 8
SEQ = 8192
DEPTH = 2

MIX_WIDTH = D_MODEL
WIDTH_A = MIX_WIDTH // 2
WIDTH_B = MIX_WIDTH - WIDTH_A
HEADS_A = 4
HEAD_DIM_A = WIDTH_A // HEADS_A
GROUPS_B = 4
CHUNK = 128
CONV_K = 3
PLE_DIM = 256
EPS = 1e-6
SPLITS = [WIDTH_A, WIDTH_A, WIDTH_A, WIDTH_B, WIDTH_B, WIDTH_B, WIDTH_B]
PROJ_WIDTH = sum(SPLITS)

kernel_name = "hybrid_sgu_shortconv_ple_trunk"


def rmsnorm(x, g):
    xf = x.astype(jnp.float32)
    y = xf * lax.rsqrt(jnp.mean(xf * xf, axis=-1, keepdims=True) + EPS)
    return (y * g.astype(jnp.float32)).astype(x.dtype)


def layernorm(x, g, b):
    xf = x.astype(jnp.float32)
    mu = jnp.mean(xf, axis=-1, keepdims=True)
    xc = xf - mu
    var = jnp.mean(xc * xc, axis=-1, keepdims=True)
    y = xc * lax.rsqrt(var + EPS)
    return (y * g.astype(jnp.float32) + b.astype(jnp.float32)).astype(x.dtype)


def spatial_gating(u, v, ln_g, ln_b, w_s, b_s):
    bsz, s_len, _ = v.shape
    n_chunks = s_len // CHUNK
    v = layernorm(v, ln_g, ln_b)
    vh = v.reshape(bsz, n_chunks, CHUNK, HEADS_A, HEAD_DIM_A)
    mask = jnp.tril(jnp.ones((CHUNK, CHUNK), dtype=w_s.dtype))
    ws = w_s * mask[None]
    mixed = jnp.einsum('hts,bnshd->bnthd', ws, vh)
    mixed = mixed + jnp.transpose(b_s)[None, None, :, :, None]
    return u * mixed.reshape(bsz, s_len, WIDTH_A)


def gated_short_conv(h, gate_b, gate_c, conv_w):
    s_len = h.shape[1]
    xc = gate_c * h
    xp = jnp.pad(xc, ((0, 0), (CONV_K - 1, 0), (0, 0)))
    y = xp[:, 0:s_len] * conv_w[:, 0]
    for k in range(1, CONV_K):
        y = y + xp[:, k:k + s_len] * conv_w[:, k]
    return gate_b * y


def setup_inputs(seed: int = 0) -> dict:
    key = jax.random.key(seed)
    ks = jax.random.split(key, 16)
    f32 = jnp.float32
    x = jax.random.normal(ks[0], (BATCH, SEQ, D_MODEL), f32)
    p = jax.random.normal(ks[1], (DEPTH, BATCH, SEQ, PLE_DIM), f32)
    norm_g = 1.0 + 0.02 * jax.random.normal(ks[2], (DEPTH, D_MODEL), f32)
    w_in = jax.random.normal(ks[3], (DEPTH, D_MODEL, PROJ_WIDTH), f32) * D_MODEL ** -0.5
    ln_v_g = 1.0 + 0.02 * jax.random.normal(ks[4], (DEPTH, WIDTH_A), f32)
    ln_v_b = 0.02 * jax.random.normal(ks[5], (DEPTH, WIDTH_A), f32)
    w_s = 0.5 * jax.random.normal(ks[6], (DEPTH, HEADS_A, CHUNK, CHUNK), f32) * CHUNK ** -0.5
    b_s = 1.0 + 0.1 * jax.random.normal(ks[7], (DEPTH, HEADS_A, CHUNK), f32)
    conv_w = jax.random.normal(ks[8], (DEPTH, WIDTH_B, CONV_K), f32) * CONV_K ** -0.5
    w_out = jax.random.normal(ks[9], (DEPTH, MIX_WIDTH, D_MODEL), f32) * MIX_WIDTH ** -0.5
    ple_norm_g = 1.0 + 0.02 * jax.random.normal(ks[10], (DEPTH, D_MODEL), f32)
    w_ple_gate = jax.random.normal(ks[11], (DEPTH, D_MODEL, D_MODEL), f32) * D_MODEL ** -0.5
    w_ple_proj = 0.5 * jax.random.normal(ks[12], (DEPTH, PLE_DIM, D_MODEL), f32) * PLE_DIM ** -0.5
    final_g = 1.0 + 0.02 * jax.random.normal(ks[13], (D_MODEL,), f32)
    return {"x": x, "p": p, "norm_g": norm_g, "w_in": w_in, "ln_v_g": ln_v_g,
            "ln_v_b": ln_v_b, "w_s": w_s, "b_s": b_s, "conv_w": conv_w,
            "w_out": w_out, "ple_norm_g": ple_norm_g, "w_ple_gate": w_ple_gate,
            "w_ple_proj": w_ple_proj, "final_g": final_g}


def reference(x, p, norm_g, w_in, ln_v_g, ln_v_b, w_s, b_s, conv_w, w_out,
              ple_norm_g, w_ple_gate, w_ple_proj, final_g):
    split_idx = list(np.cumsum(SPLITS)[:-1])
    for i in range(DEPTH):
        hn = rmsnorm(x, norm_g[i])
        proj = hn @ w_in[i]
        u_a, v_a, z_a, h_b, gb, gc, z_b = jnp.split(proj, split_idx, axis=-1)
        out_a = spatial_gating(u_a, v_a, ln_v_g[i], ln_v_b[i], w_s[i], b_s[i]) * jax.nn.silu(z_a)
        out_b = gated_short_conv(h_b, gb, gc, conv_w[i]) * jax.nn.silu(z_b)
        x = x + jnp.concatenate([out_a, out_b], axis=-1) @ w_out[i]
        gate = jax.nn.sigmoid(rmsnorm(x, ple_norm_g[i]) @ w_ple_gate[i])
        x = x + gate * (p[i] @ w_ple_proj[i])
    return rmsnorm(x, final_g)
```

```cpp
#include <hip/hip_runtime.h>
#include <hip/hip_cooperative_groups.h>
#include <cstdio>
#include <cstdint>
namespace cg = cooperative_groups;
namespace pg8 {
#define PG8_LAS __attribute__((address_space(3)))
typedef unsigned short bf16_t;
typedef short bf16x8 __attribute__((ext_vector_type(8)));
typedef float f32x4 __attribute__((ext_vector_type(4)));
typedef unsigned u32x4 __attribute__((ext_vector_type(4)));
constexpr int BM = 256, BK = 64, HALF = 128, HTB = HALF * BK * 2  , STAGE_BYTES = 8 * HTB, NXCD = 8, WGM = 8;

__host__ __device__ __forceinline__ int lds_byte(int r, int c) { const int st = (r >> 4) * 2 + (c >> 5), rr = r & 15, cc = c & 31, ob = rr * 64 + cc * 2; return st * 1024 + (ob ^ (((ob >> 9) & 1) << 5)); }
__host__ __device__ __forceinline__ void stage_rc(int b, int& R, int& C) { const int st = b / 1024, sb = b % 1024, swz = sb ^ (((sb >> 9) & 1) << 5); R = (st >> 1) * 16 + swz / 64; C = (st & 1) * 32 + (swz % 64) / 2; }
__host__ __device__ __forceinline__ int perm32(int rho) { const int n = rho >> 4, i = rho & 15; return 8 * (i >> 2) + 4 * n + (i & 3); }

struct Unit { int pm, pn; };
struct Gemm { const bf16_t* A; const bf16_t* Bt; int M, N, K; };

struct StaticOrder {
    int nM, nN, nwg, G, c;
    __host__ __device__ void init(int M, int N, int G_, int c_) { nM = M / BM; nN = N / BM; nwg = nM * nN; G = G_; c = c_; }
    __host__ __device__ bool next(int i, Unit& u) const {
        const long L = (long)i * G + c; if (L >= nwg) return false;
        int wgid = (int)L; { const int q = nwg / NXCD, r = nwg % NXCD, xcd = wgid % NXCD, off = wgid / NXCD; wgid = (xcd < r ? xcd * (q + 1) : r * (q + 1) + (xcd - r) * q) + off; }
        const int nig = WGM * nN, gid = wgid / nig, fm = gid * WGM, gsz = (nM - fm) < WGM ? (nM - fm) : WGM;
        u.pm = fm + ((wgid % nig) % gsz); u.pn = (wgid % nig) / gsz; return true;
    }
    __device__ __forceinline__ void a_ready(const Unit&) const {}
    __device__ __forceinline__ void done(const Unit&) const {}
};

__device__ __forceinline__ unsigned cvt_pk_bf16(float lo, float hi) { unsigned r; asm volatile("v_cvt_pk_bf16_f32 %0, %1, %2" : "=v"(r) : "v"(lo), "v"(hi)); return r; }
typedef float f32x2 __attribute__((ext_vector_type(2)));
typedef unsigned u32x2 __attribute__((ext_vector_type(2)));
__device__ __forceinline__ float row_rstd16(const float* ssq, int r) {
    const f32x4* p = (const f32x4*)(ssq + (size_t)r * 16);
    const f32x4 a = p[0], b = p[1], c = p[2], d = p[3];
    const float s = (((a[0] + a[1]) + (a[2] + a[3])) + ((b[0] + b[1]) + (b[2] + b[3]))) + (((c[0] + c[1]) + (c[2] + c[3])) + ((d[0] + d[1]) + (d[2] + d[3])));
    return __builtin_amdgcn_rsqf(s * (1.0f / 1024.0f) + 1e-6f);
}
__device__ __forceinline__ float sigmoid_f(float v) { return __builtin_amdgcn_rcpf(1.0f + __builtin_amdgcn_exp2f(v * -1.4426950408889634f)); }
__device__ __forceinline__ float shfl_xor_l(float v, int mask, int lane) { return __int_as_float(__builtin_amdgcn_ds_bpermute((lane ^ mask) << 2, __float_as_int(v))); }
__device__ __forceinline__ float bf_lo(unsigned w) { return __uint_as_float(w << 16); }
__device__ __forceinline__ float bf_hi(unsigned w) { return __uint_as_float(w & 0xffff0000u); }

struct EpiPlainBf16 {
    static constexpr bool PERM = true, AFTER_DRAIN = false;
    bf16_t* O; int ldc;
    __device__ __forceinline__ void operator()(const f32x4 (&acc)[2][2][4][2], const Unit& u, int wr, int wc, int fr, int fq) const {
        const unsigned boff = (unsigned)((((u.pm * 4 + u.pn) * 8 + wr * 4 + wc) * 16) * 64 + fq * 16 + fr) * 16u;
#pragma unroll
        for (int ai = 0; ai < 2; ++ai)
#pragma unroll
            for (int m = 0; m < 4; ++m)
#pragma unroll
                for (int bj = 0; bj < 2; ++bj) {
                    const f32x4 v0 = acc[ai][bj][m][0], v1 = acc[ai][bj][m][1];
                    u32x4 w; w.x = cvt_pk_bf16(v0[0], v0[1]); w.y = cvt_pk_bf16(v0[2], v0[3]); w.z = cvt_pk_bf16(v1[0], v1[1]); w.w = cvt_pk_bf16(v1[2], v1[3]);
                    __builtin_nontemporal_store(w, (u32x4*)((char*)O + (boff + (unsigned)(((ai * 4 + m) * 2 + bj) * 1024))));
                }
    }
};
struct EpiProj {
    static constexpr bool PERM = true, AFTER_DRAIN = false;
    bf16_t* V; bf16_t* GA; bf16_t* MIXB; const PG8_LAS float* RS; const PG8_LAS float* CWL; PG8_LAS float* HALO; float* HXL; float* HX0; float* HG0;
    __device__ __forceinline__ void operator()(const f32x4 (&acc)[2][2][4][2], const Unit& u, int wr, int wc, int fr, int fq) const {
        const int row0 = u.pm * BM + wr * 64 + fr;
        float rs[2][4];
        const PG8_LAS float* rsp = RS + ((u.pm >> 3) & 3) * 256 + wr * 64 + fr;
#pragma unroll
        for (int ai = 0; ai < 2; ++ai)
#pragma unroll
            for (int m = 0; m < 4; ++m) rs[ai][m] = rsp[ai * HALF + m * 16];
        if (u.pn < 2) {
#pragma unroll
            for (int ai = 0; ai < 2; ++ai)
#pragma unroll
                for (int m = 0; m < 4; ++m) {
                    bf16_t* rowp = V + (size_t)(row0 + ai * HALF + m * 16) * 512 + u.pn * 256 + wc * 32 + 8 * fq; const float sc = rs[ai][m];
#pragma unroll
                    for (int bj = 0; bj < 2; ++bj) {
                        const f32x4 v0 = acc[ai][bj][m][0] * sc, v1 = acc[ai][bj][m][1] * sc;
                        u32x4 w; w.x = cvt_pk_bf16(v0[0], v0[1]); w.y = cvt_pk_bf16(v0[2], v0[3]); w.z = cvt_pk_bf16(v1[0], v1[1]); w.w = cvt_pk_bf16(v1[2], v1[3]);
                        *(u32x4*)(rowp + bj * HALF) = w;
                    }
                }
        } else if (u.pn < 6) {
#pragma unroll
            for (int ai = 0; ai < 2; ++ai)
#pragma unroll
                for (int m = 0; m < 4; ++m) {
                    bf16_t* rowp = GA + (size_t)(row0 + ai * HALF + m * 16) * 512 + (u.pn - 2) * 128 + wc * 32 + 8 * fq; const float sc = rs[ai][m];
                    float o[8];
#pragma unroll
                    for (int n = 0; n < 2; ++n)
#pragma unroll
                        for (int j = 0; j < 4; ++j) { const float uu = acc[ai][0][m][n][j] * sc, zz = acc[ai][1][m][n][j] * sc; o[4 * n + j] = uu * zz * sigmoid_f(zz); }
                    u32x4 w; w.x = cvt_pk_bf16(o[0], o[1]); w.y = cvt_pk_bf16(o[2], o[3]); w.z = cvt_pk_bf16(o[4], o[5]); w.w = cvt_pk_bf16(o[6], o[7]);
                    *(u32x4*)rowp = w;
                }
        } else {
            const int ch0 = (u.pn - 6) * 64 + wc * 16 + 4 * fq, lane = fq * 16 + fr;
            float xc[2][4][4], gz[2][4][4];
#pragma unroll
            for (int ai = 0; ai < 2; ++ai)
#pragma unroll
                for (int m = 0; m < 4; ++m) { const float sc = rs[ai][m];
#pragma unroll
                    for (int j = 0; j < 4; ++j) { const float hh = acc[ai][0][m][0][j] * sc, bb = acc[ai][0][m][1][j] * sc, cc = acc[ai][1][m][0][j] * sc, zz = acc[ai][1][m][1][j] * sc;
                        xc[ai][m][j] = cc * hh; gz[ai][m][j] = bb * zz * sigmoid_f(zz); } }
            float tw[12];
            { const PG8_LAS f32x4* cwp = (const PG8_LAS f32x4*)(CWL + 3 * ch0); const f32x4 c0 = cwp[0], c1 = cwp[1], c2 = cwp[2];
#pragma unroll
              for (int k = 0; k < 4; ++k) { tw[k] = c0[k]; tw[4 + k] = c1[k]; tw[8 + k] = c2[k]; } }
            if (fr >= 14) {
#pragma unroll
                for (int ai = 0; ai < 2; ++ai) *(PG8_LAS f32x4*)(HALO + (((ai * 2 + wr) * 2 + (fr - 14)) * 64 + wc * 16 + 4 * fq)) = (f32x4){xc[ai][3][0], xc[ai][3][1], xc[ai][3][2], xc[ai][3][3]};
                if (wr == 1) *(f32x4*)(HXL + ((size_t)u.pm * 2 + (fr - 14)) * 512 + ch0) = (f32x4){xc[1][3][0], xc[1][3][1], xc[1][3][2], xc[1][3][3]};
            }
            if (wr == 0 && fr < 2) {
                *(f32x4*)(HX0 + ((size_t)u.pm * 2 + fr) * 512 + ch0) = (f32x4){xc[0][0][0], xc[0][0][1], xc[0][0][2], xc[0][0][3]};
                *(f32x4*)(HG0 + ((size_t)u.pm * 2 + fr) * 512 + ch0) = (f32x4){gz[0][0][0], gz[0][0][1], gz[0][0][2], gz[0][0][3]};
            }
            asm volatile("s_waitcnt lgkmcnt(0)" ::: "memory"); __builtin_amdgcn_s_barrier(); asm volatile("" ::: "memory");
#pragma unroll
            for (int ai = 0; ai < 2; ++ai) {
                f32x4 p1 = (f32x4){0.f, 0.f, 0.f, 0.f}, p2 = p1;
                if (wr == 1) { p2 = *(const PG8_LAS f32x4*)(HALO + (((ai * 2 + 0) * 2 + 0) * 64 + wc * 16 + 4 * fq)); p1 = *(const PG8_LAS f32x4*)(HALO + (((ai * 2 + 0) * 2 + 1) * 64 + wc * 16 + 4 * fq)); }
                else if (ai == 1) { p2 = *(const PG8_LAS f32x4*)(HALO + (((0 * 2 + 1) * 2 + 0) * 64 + wc * 16 + 4 * fq)); p1 = *(const PG8_LAS f32x4*)(HALO + (((0 * 2 + 1) * 2 + 1) * 64 + wc * 16 + 4 * fq)); }
                float r1p[4], r2p[4];
#pragma unroll
                for (int j = 0; j < 4; ++j) { r1p[j] = p1[j]; r2p[j] = (fr == 1) ? p1[j] : p2[j]; }
#pragma unroll
                for (int m = 0; m < 4; ++m) {
                    float o[4];
#pragma unroll
                    for (int j = 0; j < 4; ++j) {
                        const float cur = xc[ai][m][j];
                        const float r1c = __int_as_float(__builtin_amdgcn_update_dpp(0, __float_as_int(cur), 0x121  , 0xf, 0xf, false)), r2c = __int_as_float(__builtin_amdgcn_update_dpp(0, __float_as_int(cur), 0x122  , 0xf, 0xf, false));
                        const float x1 = (fr >= 1) ? r1c : r1p[j], x2 = (fr >= 2) ? r2c : r2p[j];
                        o[j] = gz[ai][m][j] * (tw[3 * j] * x2 + tw[3 * j + 1] * x1 + tw[3 * j + 2] * cur);
                        r1p[j] = r1c; r2p[j] = r2c;
                    }
                    u32x2 w; w.x = cvt_pk_bf16(o[0], o[1]); w.y = cvt_pk_bf16(o[2], o[3]);
                    *(u32x2*)(MIXB + (size_t)(row0 + ai * HALF + m * 16) * 1024 + 512 + ch0) = w;
                }
            }
        }
    }
};
template <bool F32IN> struct EpiResid {
    static constexpr bool PERM = true, AFTER_DRAIN = false;
    const float* xin_f; const bf16_t* xin_b; bf16_t* xb; float* ssq_out;
    __device__ __forceinline__ void operator()(const f32x4 (&acc)[2][2][4][2], const Unit& u, int wr, int wc, int fr, int fq) const {
        static_assert(!F32IN, "the batched epilogue reads the bf16 residual");
        const int row0 = u.pm * BM + wr * 64 + fr, col0 = u.pn * BM + wc * 32 + 8 * fq, lane = fq * 16 + fr;
        u32x4 xwv[2][4][2]; float ssum[2][4];
#pragma unroll
        for (int ai = 0; ai < 2; ++ai)
#pragma unroll
            for (int m = 0; m < 4; ++m)
#pragma unroll
                for (int bj = 0; bj < 2; ++bj) xwv[ai][m][bj] = *(const u32x4*)(xin_b + (size_t)(row0 + ai * HALF + m * 16) * 1024 + col0 + bj * HALF);
        asm volatile("" ::: "memory");
#pragma unroll
        for (int ai = 0; ai < 2; ++ai)
#pragma unroll
            for (int m = 0; m < 4; ++m) {
                f32x2 sq = (f32x2){0.f, 0.f};
#pragma unroll
                for (int bj = 0; bj < 2; ++bj) {
                    const unsigned xws[4] = {xwv[ai][m][bj].x, xwv[ai][m][bj].y, xwv[ai][m][bj].z, xwv[ai][m][bj].w};
                    unsigned wout[4];
#pragma unroll
                    for (int h2 = 0; h2 < 4; ++h2) {
                        const f32x4 av = acc[ai][bj][m][h2 >> 1];
                        const f32x2 v = (f32x2){av[2 * (h2 & 1)], av[2 * (h2 & 1) + 1]} + (f32x2){bf_lo(xws[h2]), bf_hi(xws[h2])};
                        sq = v * v + sq;
                        wout[h2] = cvt_pk_bf16(v.x, v.y);
                    }
                    u32x4 w; w.x = wout[0]; w.y = wout[1]; w.z = wout[2]; w.w = wout[3];
                    *(u32x4*)(xb + (size_t)(row0 + ai * HALF + m * 16) * 1024 + col0 + bj * HALF) = w;
                }
                ssum[ai][m] = sq.x + sq.y;
            }
        asm volatile("" ::: "memory");
        float t16[2][4];
#pragma unroll
        for (int ai = 0; ai < 2; ++ai)
#pragma unroll
            for (int m = 0; m < 4; ++m) t16[ai][m] = shfl_xor_l(ssum[ai][m], 16, lane);
#pragma unroll
        for (int ai = 0; ai < 2; ++ai)
#pragma unroll
            for (int m = 0; m < 4; ++m) ssum[ai][m] += t16[ai][m];
#pragma unroll
        for (int ai = 0; ai < 2; ++ai)
#pragma unroll
            for (int m = 0; m < 4; ++m) t16[ai][m] = shfl_xor_l(ssum[ai][m], 32, lane);
        if (fq == 0) {
#pragma unroll
            for (int ai = 0; ai < 2; ++ai)
#pragma unroll
                for (int m = 0; m < 4; ++m) ssq_out[(size_t)(row0 + ai * HALF + m * 16) * 16 + u.pn * 4 + wc] = ssum[ai][m] + t16[ai][m];
        }
    }
};
struct EpiGate {
    static constexpr bool PERM = true, AFTER_DRAIN = false;
    const bf16_t* xb_in; const bf16_t* pp; bf16_t* xb_out; const PG8_LAS float* RS; float* ssq_out;
    __device__ __forceinline__ void operator()(const f32x4 (&acc)[2][2][4][2], const Unit& u, int wr, int wc, int fr, int fq) const {
        const int row0 = u.pm * BM + wr * 64 + fr, col0 = u.pn * BM + wc * 32 + 8 * fq, lane = fq * 16 + fr;
        const unsigned poff = (unsigned)((((u.pm * 4 + u.pn) * 8 + wr * 4 + wc) * 16) * 64 + fq * 16 + fr) * 16u;
        float cm[2][4], ssum[2][4];
        { const PG8_LAS float* rsp = RS + ((u.pm >> 3) & 3) * 256 + wr * 64 + fr;
#pragma unroll
          for (int ai = 0; ai < 2; ++ai)
#pragma unroll
              for (int m = 0; m < 4; ++m) cm[ai][m] = rsp[ai * HALF + m * 16] * -1.4426950408889634f; }
        u32x4 pwv[2][2][2], xwv[2][2][2];
#define PG8_GATE_LOAD(QQ, BUF) do { _Pragma("unroll") for (int mm = 0; mm < 2; ++mm) _Pragma("unroll") for (int bj = 0; bj < 2; ++bj) { const int ai_ = (QQ) >> 1, m_ = 2 * ((QQ) & 1) + mm; \
            pwv[BUF][mm][bj] = __builtin_nontemporal_load((const u32x4*)((const char*)pp + (poff + (unsigned)(((ai_ * 4 + m_) * 2 + bj) * 1024)))); \
            xwv[BUF][mm][bj] = *(const u32x4*)(xb_in + (size_t)(row0 + ai_ * HALF + m_ * 16) * 1024 + col0 + bj * HALF); } } while (0)
        PG8_GATE_LOAD(0, 0); PG8_GATE_LOAD(1, 1);
        asm volatile("" ::: "memory");
#pragma unroll
        for (int qq = 0; qq < 4; ++qq) {
            const int ai = qq >> 1, buf = qq & 1;
            u32x4 wst[2][2]; float sst[2];
#pragma unroll
            for (int mm = 0; mm < 2; ++mm) {
                const int m = 2 * (qq & 1) + mm;
                f32x2 sq = (f32x2){0.f, 0.f};
#pragma unroll
                for (int bj = 0; bj < 2; ++bj) {
                    const unsigned pws[4] = {pwv[buf][mm][bj].x, pwv[buf][mm][bj].y, pwv[buf][mm][bj].z, pwv[buf][mm][bj].w}, xws[4] = {xwv[buf][mm][bj].x, xwv[buf][mm][bj].y, xwv[buf][mm][bj].z, xwv[buf][mm][bj].w};
                    unsigned wout[4];
#pragma unroll
                    for (int h2 = 0; h2 < 4; ++h2) {
                        const f32x4 av = acc[ai][bj][m][h2 >> 1];
                        const f32x2 t = (f32x2){av[2 * (h2 & 1)], av[2 * (h2 & 1) + 1]} * cm[ai][m];
                        f32x2 e2; e2.x = __builtin_amdgcn_exp2f(t.x); e2.y = __builtin_amdgcn_exp2f(t.y);
                        const f32x2 d = e2 + 1.0f;
                        f32x2 sg; sg.x = __builtin_amdgcn_rcpf(d.x); sg.y = __builtin_amdgcn_rcpf(d.y);
                        const f32x2 pf = (f32x2){bf_lo(pws[h2]), bf_hi(pws[h2])}, xf = (f32x2){bf_lo(xws[h2]), bf_hi(xws[h2])};
                        const f32x2 v = sg * pf + xf;
                        sq = v * v + sq;
                        wout[h2] = cvt_pk_bf16(v.x, v.y);
                    }
                    wst[mm][bj].x = wout[0]; wst[mm][bj].y = wout[1]; wst[mm][bj].z = wout[2]; wst[mm][bj].w = wout[3];
                }
                sst[mm] = sq.x + sq.y;
            }
            asm volatile("" ::: "memory");
            if (qq == 0) PG8_GATE_LOAD(2, 0);
            if (qq == 1) PG8_GATE_LOAD(3, 1);
            asm volatile("" ::: "memory");
#pragma unroll
            for (int mm = 0; mm < 2; ++mm) { const int m = 2 * (qq & 1) + mm; ssum[ai][m] = sst[mm];
#pragma unroll
                for (int bj = 0; bj < 2; ++bj) *(u32x4*)(xb_out + (size_t)(row0 + ai * HALF + m * 16) * 1024 + col0 + bj * HALF) = wst[mm][bj]; }
            asm volatile("" ::: "memory");
        }
#undef PG8_GATE_LOAD
        float t16[2][4];
#pragma unroll
        for (int ai = 0; ai < 2; ++ai)
#pragma unroll
            for (int m = 0; m < 4; ++m) t16[ai][m] = shfl_xor_l(ssum[ai][m], 16, lane);
#pragma unroll
        for (int ai = 0; ai < 2; ++ai)
#pragma unroll
            for (int m = 0; m < 4; ++m) ssum[ai][m] += t16[ai][m];
#pragma unroll
        for (int ai = 0; ai < 2; ++ai)
#pragma unroll
            for (int m = 0; m < 4; ++m) t16[ai][m] = shfl_xor_l(ssum[ai][m], 32, lane);
        if (fq == 0) {
#pragma unroll
            for (int ai = 0; ai < 2; ++ai)
#pragma unroll
                for (int m = 0; m < 4; ++m) ssq_out[(size_t)(row0 + ai * HALF + m * 16) * 16 + u.pn * 4 + wc] = ssum[ai][m] + t16[ai][m];
        }
    }
};

struct EpiNull {
    static constexpr bool PERM = true, AFTER_DRAIN = false;
    float* sink;
    __device__ __forceinline__ void operator()(const f32x4 (&acc)[2][2][4][2], const Unit& u, int wr, int wc, int fr, int fq) const {
        float s = 0.f;
#pragma unroll
        for (int ai = 0; ai < 2; ++ai)
#pragma unroll
            for (int bj = 0; bj < 2; ++bj)
#pragma unroll
                for (int m = 0; m < 4; ++m)
#pragma unroll
                    for (int n = 0; n < 2; ++n) s += (acc[ai][bj][m][n][0] + acc[ai][bj][m][n][1]) + (acc[ai][bj][m][n][2] + acc[ai][bj][m][n][3]);
        if (s == 123456.789f) sink[u.pm + fr] = s;
    }
};
template <class Epi, class Sched, bool ALIGN_EPI = false, bool SP2 = false>
__device__ __forceinline__ void gemm_phase(PG8_LAS unsigned char* lds, const Gemm g, const Sched& S, const Epi& E, const int wid_in) {
    int lane_; asm volatile("v_mbcnt_lo_u32_b32 %0, -1, 0\n\tv_mbcnt_hi_u32_b32 %0, -1, %0" : "=v"(lane_));
    const int wid = wid_in, lane = lane_, tid = wid * 64 + lane, wr = wid >> 2, wc = wid & 3, fr = lane & 15, fq = lane >> 4;
    const int K = g.K, nt = K / BK;
    unsigned voffA[2], voffB[2];
#pragma unroll
    for (int i = 0; i < 2; ++i) { int R, C; stage_rc(tid * 16 + i * 8192, R, C); const int Rb = Epi::PERM ? ((R & ~31) + perm32(R & 31)) : R;
        voffA[i] = (unsigned)(R * K + C) * 2u; voffB[i] = (unsigned)(Rb * K + C) * 2u; }
    const size_t kstep = (size_t)(BK * 2);
    const size_t hstep = (size_t)HALF * K * 2;
    const size_t tstep = 2 * hstep;
    const unsigned ldsw = (unsigned)wid * 1024u;
    const int aoff = lds_byte(wr * 64 + fr, fq * 8), boff = lds_byte(wc * 32 + fr, fq * 8);
#define PG8_SA(b, h) (((b) * 2 + (h)) * HTB)
#define PG8_SB(b, h) ((4 + (b) * 2 + (h)) * HTB)
#define PG8_STAGE(bufoff, gbase, voff) do { _Pragma("unroll") for (int _i = 0; _i < 2; ++_i) \
        __builtin_amdgcn_global_load_lds((const unsigned*)((const char*)(gbase) + (voff)[_i]), (PG8_LAS unsigned*)(lds + (bufoff) + ldsw + _i * 8192), 16, 0, 0); } while (0)
#define PG8_LDA(dst, b, h) do { _Pragma("unroll") for (int m = 0; m < 4; ++m) _Pragma("unroll") for (int k = 0; k < 2; ++k) dst[m][k] = *(const PG8_LAS bf16x8*)(lds + PG8_SA(b, h) + aoff + m * 2048 + k * 1024); } while (0)
#define PG8_LDB(dst, b, h) do { _Pragma("unroll") for (int n = 0; n < 2; ++n) _Pragma("unroll") for (int k = 0; k < 2; ++k) dst[n][k] = *(const PG8_LAS bf16x8*)(lds + PG8_SB(b, h) + boff + n * 2048 + k * 1024); } while (0)
#define PG8_MMA(ai, bj, At, Bt) do { __builtin_amdgcn_s_setprio(1); _Pragma("unroll") for (int m = 0; m < 4; ++m) _Pragma("unroll") for (int n = 0; n < 2; ++n) _Pragma("unroll") for (int k = 0; k < 2; ++k) \
        acc[ai][bj][m][n] = __builtin_amdgcn_mfma_f32_16x16x32_bf16(Bt[n][k], At[m][k], acc[ai][bj][m][n], 0, 0, 0); __builtin_amdgcn_s_setprio(0); } while (0)
#define PG8_WAIT_V(n) asm volatile("s_waitcnt vmcnt(" #n ")" ::: "memory")
#define PG8_WAIT_L(n) asm volatile("s_waitcnt lgkmcnt(" #n ")" ::: "memory")
#define PG8_BAR __builtin_amdgcn_s_barrier()
#define PG8_SCHED __builtin_amdgcn_sched_barrier(0)
    Unit cur, nxt; int ui = 0;
    if (!S.next(0, cur)) return;
    f32x4 acc[2][2][4][2];
#pragma unroll
    for (int a = 0; a < 2; ++a)
#pragma unroll
        for (int b = 0; b < 2; ++b)
#pragma unroll
            for (int m = 0; m < 4; ++m)
#pragma unroll
                for (int n = 0; n < 2; ++n) acc[a][b][m][n] = (f32x4){0.f, 0.f, 0.f, 0.f};
    bf16x8 At[4][2], B0[2][2], B1[2][2];
    const char* cA = (const char*)g.A + (size_t)cur.pm * tstep; const char* cB = (const char*)g.Bt + (size_t)cur.pn * tstep;
    S.a_ready(cur);
    if constexpr (SP2) {
        PG8_STAGE(PG8_SB(0, 0), cB, voffB); PG8_STAGE(PG8_SB(0, 1), cB + hstep, voffB); PG8_STAGE(PG8_SA(0, 0), cA, voffA); PG8_STAGE(PG8_SA(0, 1), cA + hstep, voffA);
        if (wr == 1) PG8_BAR;
        PG8_WAIT_V(2); PG8_BAR;
        PG8_STAGE(PG8_SB(1, 0), cB + kstep, voffB); PG8_STAGE(PG8_SA(1, 0), cA + kstep, voffA); PG8_STAGE(PG8_SB(1, 1), cB + hstep + kstep, voffB);
        PG8_WAIT_V(6); PG8_BAR;
    } else {
        PG8_STAGE(PG8_SB(0, 0), cB, voffB); PG8_STAGE(PG8_SA(0, 0), cA, voffA); PG8_STAGE(PG8_SB(0, 1), cB + hstep, voffB); PG8_STAGE(PG8_SA(0, 1), cA + hstep, voffA);
        if (wr == 1) PG8_BAR;
        PG8_WAIT_V(4); PG8_BAR;
        PG8_STAGE(PG8_SB(1, 0), cB + kstep, voffB); PG8_STAGE(PG8_SA(1, 0), cA + kstep, voffA); PG8_STAGE(PG8_SB(1, 1), cB + hstep + kstep, voffB);
        PG8_WAIT_V(6); PG8_BAR;
    }
    for (;;) {
        const bool has_next = S.next(ui + 1, nxt);
        const char* nA = has_next ? (const char*)g.A + (size_t)nxt.pm * tstep : cA; const char* nB = has_next ? (const char*)g.Bt + (size_t)nxt.pn * tstep : cB;
        for (int t = 0; t < nt; t += 2) {
            const bool last = (t == nt - 2);
            const char* a1 = cA + (size_t)(t + 1) * kstep;
            const char* a2 = last ? nA : cA + (size_t)(t + 2) * kstep; const char* b2 = last ? nB : cB + (size_t)(t + 2) * kstep;
            const char* a3 = a2 + kstep; const char* b3 = b2 + kstep;
            if (last && has_next) S.a_ready(nxt);
            if constexpr (SP2) {
            PG8_LDB(B0, 0, 0); PG8_LDB(B1, 0, 1); PG8_SCHED; PG8_LDA(At, 0, 0); PG8_STAGE(PG8_SA(1, 1), a1 + hstep, voffA);
            PG8_WAIT_V(8); PG8_WAIT_L(0); PG8_BAR; PG8_MMA(0, 0, At, B0); PG8_MMA(0, 1, At, B1); PG8_BAR; PG8_SCHED;
            PG8_LDA(At, 0, 1); PG8_STAGE(PG8_SB(0, 0), b2, voffB); PG8_STAGE(PG8_SB(0, 1), b2 + hstep, voffB); PG8_STAGE(PG8_SA(0, 0), a2, voffA);
            PG8_WAIT_V(8); PG8_WAIT_L(0); PG8_BAR; PG8_MMA(1, 0, At, B0); PG8_MMA(1, 1, At, B1); PG8_BAR; PG8_SCHED;
            PG8_LDB(B0, 1, 0); PG8_LDB(B1, 1, 1); PG8_SCHED; PG8_LDA(At, 1, 0); PG8_STAGE(PG8_SA(0, 1), a2 + hstep, voffA);
            PG8_WAIT_V(8); PG8_WAIT_L(0); PG8_BAR; PG8_MMA(0, 0, At, B0); PG8_MMA(0, 1, At, B1); PG8_BAR; PG8_SCHED;
            PG8_LDA(At, 1, 1); PG8_STAGE(PG8_SB(1, 0), b3, voffB); PG8_STAGE(PG8_SB(1, 1), b3 + hstep, voffB); PG8_STAGE(PG8_SA(1, 0), a3, voffA);
            PG8_WAIT_V(8); PG8_WAIT_L(0); PG8_BAR; PG8_MMA(1, 0, At, B0); PG8_MMA(1, 1, At, B1); PG8_BAR; PG8_SCHED;
            } else {
            PG8_LDB(B0, 0, 0); PG8_SCHED; PG8_LDA(At, 0, 0); PG8_STAGE(PG8_SA(1, 1), a1 + hstep, voffA);
            PG8_WAIT_L(8); PG8_BAR; PG8_WAIT_L(0); PG8_MMA(0, 0, At, B0); PG8_BAR; PG8_SCHED;
            PG8_LDB(B1, 0, 1); PG8_STAGE(PG8_SB(0, 0), b2, voffB);
            PG8_BAR; PG8_WAIT_L(0); PG8_MMA(0, 1, At, B1); PG8_BAR;
            PG8_LDA(At, 0, 1); PG8_STAGE(PG8_SA(0, 0), a2, voffA);
            PG8_BAR; PG8_WAIT_L(0); PG8_MMA(1, 0, At, B0); PG8_BAR; PG8_SCHED;
            PG8_STAGE(PG8_SB(0, 1), b2 + hstep, voffB);
            PG8_WAIT_V(6); PG8_BAR; PG8_MMA(1, 1, At, B1); PG8_BAR;
            PG8_LDB(B0, 1, 0); PG8_SCHED; PG8_LDA(At, 1, 0); PG8_STAGE(PG8_SA(0, 1), a2 + hstep, voffA);
            PG8_WAIT_L(8); PG8_BAR; PG8_WAIT_L(0); PG8_MMA(0, 0, At, B0); PG8_BAR; PG8_SCHED;
            PG8_LDB(B1, 1, 1); PG8_STAGE(PG8_SB(1, 0), b3, voffB);
            PG8_BAR; PG8_WAIT_L(0); PG8_MMA(0, 1, At, B1); PG8_BAR;
            PG8_LDA(At, 1, 1); PG8_STAGE(PG8_SA(1, 0), a3, voffA);
            PG8_BAR; PG8_WAIT_L(0); PG8_MMA(1, 0, At, B0); PG8_BAR; PG8_SCHED;
            PG8_STAGE(PG8_SB(1, 1), b3 + hstep, voffB);
            PG8_WAIT_V(6); PG8_BAR; PG8_MMA(1, 1, At, B1); PG8_BAR;
            }
        }
        if constexpr (ALIGN_EPI) { if (wr == 0) PG8_BAR; }
        if constexpr (!Epi::AFTER_DRAIN) { int l2_; asm volatile("v_mbcnt_lo_u32_b32 %0, -1, 0\n\tv_mbcnt_hi_u32_b32 %0, -1, %0" : "=v"(l2_));
            E(acc, cur, wr, wc, l2_ & 15, l2_ >> 4); S.done(cur); }
        if (!has_next) break;
#pragma unroll
        for (int a = 0; a < 2; ++a)
#pragma unroll
            for (int b = 0; b < 2; ++b)
#pragma unroll
                for (int m = 0; m < 4; ++m)
#pragma unroll
                    for (int n = 0; n < 2; ++n) acc[a][b][m][n] = (f32x4){0.f, 0.f, 0.f, 0.f};
        cur = nxt; cA = nA; cB = nB; ++ui;
        if constexpr (ALIGN_EPI) { if (wr == 1) PG8_BAR; }
    }
    PG8_WAIT_V(0);
    if constexpr (!ALIGN_EPI) { if (wr == 0) PG8_BAR; }
    PG8_BAR;
    if constexpr (Epi::AFTER_DRAIN) { E.fused(acc, cur, wr, wc, fr, fq, lds, wid, lane); S.done(cur); }
#undef PG8_SA
#undef PG8_SB
#undef PG8_STAGE
#undef PG8_LDA
#undef PG8_LDB
#undef PG8_MMA
#undef PG8_WAIT_V
#undef PG8_WAIT_L
#undef PG8_BAR
#undef PG8_SCHED
}
}

#ifndef REP_GP
#define REP_GP 1
#endif
#ifndef REP_G1
#define REP_G1 1
#endif
#ifndef REP_MIX
#define REP_MIX 1
#endif
#ifndef REP_G2
#define REP_G2 1
#endif
#ifndef REP_G3
#define REP_G3 1
#endif
#ifndef REP_PRO
#define REP_PRO 1
#endif
#define LAS __attribute__((address_space(3)))
typedef unsigned short bf16;
typedef float f32x4 __attribute__((ext_vector_type(4)));
typedef unsigned u32x4 __attribute__((ext_vector_type(4)));
typedef unsigned u32x2 __attribute__((ext_vector_type(2)));
typedef short bf16x8 __attribute__((ext_vector_type(8)));
typedef short s16x4 __attribute__((ext_vector_type(4)));
constexpr int NWAVES = 8, NTHREADS = 512;
constexpr int BATCH = 8, SEQ = 8192, D = 1024, M = BATCH * SEQ, DEPTH = 2, PW = 3584, PLE = 256;
constexpr size_t MiB = 1u << 20;
constexpr size_t WS_CTL = 0, WS_WIN = 2 * MiB, WS_WOUT = 16 * MiB, WS_WG = 20 * MiB, WS_WP = 24 * MiB, WS_WM = 26 * MiB, WS_SSQA = 27 * MiB, WS_SSQB = 31 * MiB;
constexpr size_t WS_XB0 = 64 * MiB, WS_XB1 = 192 * MiB, WS_PB = 320 * MiB, WS_PP = 384 * MiB, WS_PROJ = 512 * MiB, WS_MIX = 640 * MiB, WS_HX = 768 * MiB, WS_END = 960 * MiB;
constexpr int RING_BYTES = 131072, LDS_BYTES = 147456;

using pg8::cvt_pk_bf16; using pg8::bf_lo; using pg8::bf_hi; using pg8::sigmoid_f; using pg8::shfl_xor_l;
__device__ __forceinline__ float silu_f(float z) { return z * sigmoid_f(z); }
__device__ __forceinline__ int fresh_lane() { int l; asm volatile("v_mbcnt_lo_u32_b32 %0, -1, 0\n\tv_mbcnt_hi_u32_b32 %0, -1, %0" : "=v"(l)); return l; }

#define XB_TMO      128
#define XB_XCNT(j)  (256  + 64 * (j))
#define XB_XSUB(j)  (1280 + 64 * (j))
#define XB_XGEN(j)  (2304 + 64 * (j))
#define XB_TOP      3328
#define XB_TOPGEN   3392
#define XCD_BAR_WORDS 3456
#define XB_SPIN_CAP (1u << 18)

__device__ __forceinline__ unsigned xb_ld(unsigned* p)              { return __hip_atomic_load(p, __ATOMIC_RELAXED, __HIP_MEMORY_SCOPE_AGENT); }
__device__ __forceinline__ unsigned xb_add(unsigned* p, unsigned v) { return __hip_atomic_fetch_add(p, v, __ATOMIC_RELAXED, __HIP_MEMORY_SCOPE_AGENT); }
__device__ __forceinline__ unsigned xb_xcc_id() { return (unsigned)__builtin_amdgcn_s_getreg((3 << 11) | 20) & 0xFu; }
#define XB_SPIN(cond, bar) do { unsigned _sp = 0; while (cond) { __builtin_amdgcn_s_sleep(1); \
    if ((++_sp & 255u) == 0u) { if (xb_ld(&(bar)[XB_TMO])) break; if (_sp > XB_SPIN_CAP) { atomicAdd(&(bar)[XB_TMO], 1u); break; } } } } while (0)

struct XcdBarrier {
    unsigned* bar; unsigned x;
    volatile LAS unsigned* st;
};

__device__ __forceinline__ XcdBarrier xcd_barrier_post(unsigned* bar, volatile LAS unsigned* st) {
    XcdBarrier b; b.bar = bar; b.x = xb_xcc_id(); b.st = st;
    if (threadIdx.x == 0) (void)xb_add(&bar[XB_XCNT(b.x)], 1u);
    return b;
}
__device__ __forceinline__ void xcd_barrier_complete(unsigned* bar, unsigned x, unsigned& nloc, unsigned& nx) {
    const unsigned G = gridDim.x * gridDim.y * gridDim.z;
    unsigned sum, cnt, mine, sp = 0u;
    for (;;) {
        sum = 0u; cnt = 0u; mine = 0u;
#pragma unroll
        for (unsigned j = 0; j < 16; ++j) { const unsigned c = xb_ld(&bar[XB_XCNT(j)]); sum += c; cnt += (c > 0u) ? 1u : 0u; }
        if (sum == G) { mine = xb_ld(&bar[XB_XCNT(x)]); break; }
        __builtin_amdgcn_s_sleep(1);
        if ((++sp & 255u) == 0u) { if (xb_ld(&bar[XB_TMO])) break; if (sp > XB_SPIN_CAP) { atomicAdd(&bar[XB_TMO], 1u); break; } }
    }
    nloc = mine > 0u ? mine : 1u; nx = cnt > 0u ? cnt : 1u;
}

__device__ __forceinline__ void xcd_barrier(const XcdBarrier& b) {
    asm volatile("s_waitcnt vmcnt(0)" ::: "memory");
    __syncthreads();
    if (threadIdx.x == 0) {
        unsigned* bar = b.bar;
        __builtin_amdgcn_s_waitcnt(0);
        unsigned nloc = b.st[0], nx = b.st[1];
        if (nloc == 0u) { xcd_barrier_complete(bar, b.x, nloc, nx); b.st[0] = nloc; b.st[1] = nx; }
        const unsigned old = xb_add(&bar[XB_XSUB(b.x)], 1u);
        const unsigned gen = old / nloc;
        if (old + 1u == (gen + 1u) * nloc) {
            __builtin_amdgcn_fence(__ATOMIC_RELEASE, "agent");
            asm volatile("s_waitcnt vmcnt(0)" ::: "memory");
            const unsigned og = xb_add(&bar[XB_TOP], 1u);
            const unsigned tg = og / nx;
            if (og + 1u == (tg + 1u) * nx) xb_add(&bar[XB_TOPGEN], 1u);
            else XB_SPIN(xb_ld(&bar[XB_TOPGEN]) == tg, bar);
            __builtin_amdgcn_fence(__ATOMIC_ACQUIRE, "agent");
            xb_add(&bar[XB_XGEN(b.x)], 1u);
            asm volatile("s_waitcnt vmcnt(0)" ::: "memory");
        } else {
            XB_SPIN(xb_ld(&bar[XB_XGEN(b.x)]) == gen, bar);
            __builtin_amdgcn_fence(__ATOMIC_ACQUIRE, "agent");
            asm volatile("s_waitcnt vmcnt(0)" ::: "memory");
        }
    }
    __syncthreads();
}


__device__ __forceinline__ int win_dst_row(int s) {
    if (s < 512) return 256 * (2 + (s >> 7)) + (s & 127);
    if (s < 1024) return s - 512;
    if (s < 1536) { const int q = s - 1024; return 256 * (2 + (q >> 7)) + 128 + (q & 127); }
    const int q = s - 1536, T = q >> 9, chn = q & 511, pn = 6 + (chn >> 6), cl = chn & 63;
    return 256 * pn + 128 * (T >> 1) + 32 * (cl >> 4) + 8 * ((cl >> 2) & 3) + 4 * (T & 1) + (cl & 3);
}
template <bool PERMW> __device__ __forceinline__ void transpose_item(const float* W, int K, int N, const float* gk, bf16* WT, LAS float* scr, int item, int lane) {
    const int nblk = N / 32, kb = item / nblk, nb = item % nblk, k0 = 64 * kb, n0 = 32 * nb;
#pragma unroll 8
    for (int i = 0; i < 32; ++i) { const int kk = 2 * i + (lane >> 5); const float sc = gk ? gk[k0 + kk] : 1.0f; scr[kk * 33 + (lane & 31)] = W[(size_t)(k0 + kk) * N + n0 + (lane & 31)] * sc; }
    asm volatile("s_waitcnt lgkmcnt(0)" ::: "memory");
    const int c = lane & 7;
#pragma unroll
    for (int j = 0; j < 4; ++j) { const int n = (lane >> 3) + 8 * j; const LAS float* s = scr + (8 * c) * 33 + n;
        u32x4 o; o.x = cvt_pk_bf16(s[0 * 33], s[1 * 33]); o.y = cvt_pk_bf16(s[2 * 33], s[3 * 33]); o.z = cvt_pk_bf16(s[4 * 33], s[5 * 33]); o.w = cvt_pk_bf16(s[6 * 33], s[7 * 33]);
        const int nd = PERMW ? win_dst_row(n0 + n) : (n0 + n);
        *(u32x4*)(WT + (size_t)nd * K + k0 + 8 * c) = o; }
    asm volatile("s_waitcnt lgkmcnt(0)" ::: "memory");
}

struct Args { const float* in[14]; float* out; unsigned char* ws; };

__device__ __forceinline__ void prologue(const Args& a, LAS unsigned char* lds, int G, int bid, int wave, int lane) {
    unsigned char* ws = a.ws;
    LAS float* scr = (LAS float*)(lds + wave * 16384);
    const int gw = bid * NWAVES + wave, NGW = G * NWAVES;
    constexpr int I_IN = (D / 64) * (PW / 32), I_SQ = (D / 64) * (D / 32), I_P = (PLE / 64) * (D / 32);
    constexpr int PER_L = I_IN + 2 * I_SQ + I_P;
    for (int it = gw; it < DEPTH * PER_L; it += NGW) {
        const int l = it / PER_L; int r = it % PER_L;
        if (r < I_IN) { transpose_item<true>(a.in[3] + (size_t)l * D * PW, D, PW, a.in[2] + l * D, (bf16*)(ws + WS_WIN) + (size_t)l * PW * D, scr, r, lane); continue; } r -= I_IN;
        if (r < I_SQ) { transpose_item<false>(a.in[9] + (size_t)l * D * D, D, D, nullptr, (bf16*)(ws + WS_WOUT) + (size_t)l * D * D, scr, r, lane); continue; } r -= I_SQ;
        if (r < I_SQ) { transpose_item<false>(a.in[11] + (size_t)l * D * D, D, D, a.in[10] + l * D, (bf16*)(ws + WS_WG) + (size_t)l * D * D, scr, r, lane); continue; } r -= I_SQ;
        transpose_item<false>(a.in[12] + (size_t)l * PLE * D, PLE, D, nullptr, (bf16*)(ws + WS_WP) + (size_t)l * D * PLE, scr, r, lane);
    }
    {
        const float* wsrc = a.in[6]; bf16* WMo = (bf16*)(ws + WS_WM);
        for (int e = (bid * NTHREADS + wave * 64 + lane) * 2; e < DEPTH * 4 * 128 * 128; e += G * NTHREADS * 2) {
            const int s = e & 127, t = (e >> 7) & 127;
            const float v0 = (s <= t) ? wsrc[e] : 0.f, v1 = (s + 1 <= t) ? wsrc[e + 1] : 0.f;
            *(unsigned*)(WMo + e) = cvt_pk_bf16(v0, v1);
        }
    }
    {
        const float* x = a.in[0]; bf16* XB = (bf16*)(ws + WS_XB0); float* ssq = (float*)(ws + WS_SSQA);
        for (int m0 = gw; m0 < M; m0 += 4 * NGW) {
            f32x4 v[4][4]; float s[4];
#pragma unroll
            for (int k = 0; k < 4; ++k) { const f32x4* xr = (const f32x4*)(x + (size_t)(m0 + k * NGW) * D) + lane;
#pragma unroll
                for (int j = 0; j < 4; ++j) v[k][j] = xr[64 * j]; }
#pragma unroll
            for (int k = 0; k < 4; ++k) { s[k] = 0.f;
#pragma unroll
                for (int j = 0; j < 4; ++j) s[k] += (v[k][j][0] * v[k][j][0] + v[k][j][1] * v[k][j][1]) + (v[k][j][2] * v[k][j][2] + v[k][j][3] * v[k][j][3]); }
#pragma unroll
            for (int o = 1; o < 64; o <<= 1) {
#pragma unroll
                for (int k = 0; k < 4; ++k) s[k] += shfl_xor_l(s[k], o, lane); }
#pragma unroll
            for (int k = 0; k < 4; ++k) { const int m = m0 + k * NGW; u32x2* o8 = (u32x2*)(XB + (size_t)m * D) + lane;
#pragma unroll
                for (int j = 0; j < 4; ++j) { u32x2 w; w.x = cvt_pk_bf16(v[k][j][0], v[k][j][1]); w.y = cvt_pk_bf16(v[k][j][2], v[k][j][3]); o8[64 * j] = w; }
                if (lane < 16) ssq[(size_t)m * 16 + lane] = (lane == 0) ? s[k] : 0.f; }
        }
    }
}

__device__ __forceinline__ void p_convert_tile(const float* p_tile, bf16* pb_tile, int wave, int lane) {
    const int tid = wave * 64 + lane;
    f32x4 v0[16], v1[16];
#pragma unroll
    for (int k = 0; k < 16; ++k) { v0[k] = ((const f32x4*)p_tile)[2 * (tid + k * NTHREADS)]; v1[k] = ((const f32x4*)p_tile)[2 * (tid + k * NTHREADS) + 1]; }
    asm volatile("" ::: "memory");
#pragma unroll
    for (int k = 0; k < 16; ++k) { u32x4 w; w.x = cvt_pk_bf16(v0[k][0], v0[k][1]); w.y = cvt_pk_bf16(v0[k][2], v0[k][3]); w.z = cvt_pk_bf16(v1[k][0], v1[k][1]); w.w = cvt_pk_bf16(v1[k][2], v1[k][3]);
        ((u32x4*)pb_tile)[tid + k * NTHREADS] = w; }
}

__device__ __forceinline__ void unpack8(const u32x4 w, float (&f)[8]) {
    f[0] = bf_lo(w.x); f[1] = bf_hi(w.x); f[2] = bf_lo(w.y); f[3] = bf_hi(w.y); f[4] = bf_lo(w.z); f[5] = bf_hi(w.z); f[6] = bf_lo(w.w); f[7] = bf_hi(w.w);
}

__device__ __forceinline__ void mixer_phase(LAS unsigned char* lds, const bf16* V, const bf16* GA, const float* HXL, const float* HX0, const float* HG0, bf16* MIX, const bf16* WM, const float* lng, const float* lnb,
                                            const float* bs, const float* cw, int chunk0, int wave, int lane) {
    for (int cc = 0; cc < 2; ++cc) {
        const int chunk = chunk0 + cc;
        const int row0 = chunk * 128, rb = row0 + 16 * wave;
        u32x4 vraw[16];
#pragma unroll
        for (int rr = 0; rr < 16; ++rr) vraw[rr] = *(const u32x4*)(V + (size_t)(rb + rr) * 512 + 8 * lane);
        if (wave == 0 && (chunk & 1) == 0 && (row0 & (SEQ - 1)) != 0) {
            const int pm = chunk >> 1;
            float w0[8], w1[8], w2[8];
            { float t[24]; const f32x4* cp = (const f32x4*)(cw + 24 * lane);
#pragma unroll
              for (int i = 0; i < 6; ++i) { const f32x4 q = cp[i]; t[4 * i] = q[0]; t[4 * i + 1] = q[1]; t[4 * i + 2] = q[2]; t[4 * i + 3] = q[3]; }
#pragma unroll
              for (int j = 0; j < 8; ++j) { w0[j] = t[3 * j]; w1[j] = t[3 * j + 1]; w2[j] = t[3 * j + 2]; } }
            float xm2[8], xm1[8], x0[8], x1r[8], g0[8], g1[8];
            { const float* p = HXL + ((size_t)(pm - 1) * 2) * 512 + 8 * lane; const f32x4 a = *(const f32x4*)p, b = *(const f32x4*)(p + 4), c = *(const f32x4*)(p + 512), d = *(const f32x4*)(p + 516);
#pragma unroll
              for (int j = 0; j < 4; ++j) { xm2[j] = a[j]; xm2[4 + j] = b[j]; xm1[j] = c[j]; xm1[4 + j] = d[j]; } }
            { const float* p = HX0 + ((size_t)pm * 2) * 512 + 8 * lane; const f32x4 a = *(const f32x4*)p, b = *(const f32x4*)(p + 4), c = *(const f32x4*)(p + 512), d = *(const f32x4*)(p + 516);
#pragma unroll
              for (int j = 0; j < 4; ++j) { x0[j] = a[j]; x0[4 + j] = b[j]; x1r[j] = c[j]; x1r[4 + j] = d[j]; } }
            { const float* p = HG0 + ((size_t)pm * 2) * 512 + 8 * lane; const f32x4 a = *(const f32x4*)p, b = *(const f32x4*)(p + 4), c = *(const f32x4*)(p + 512), d = *(const f32x4*)(p + 516);
#pragma unroll
              for (int j = 0; j < 4; ++j) { g0[j] = a[j]; g0[4 + j] = b[j]; g1[j] = c[j]; g1[4 + j] = d[j]; } }
            float o0[8], o1[8];
#pragma unroll
            for (int j = 0; j < 8; ++j) { o0[j] = g0[j] * (w0[j] * xm2[j] + w1[j] * xm1[j] + w2[j] * x0[j]); o1[j] = g1[j] * (w0[j] * xm1[j] + w1[j] * x0[j] + w2[j] * x1r[j]); }
            u32x4 ow; ow.x = cvt_pk_bf16(o0[0], o0[1]); ow.y = cvt_pk_bf16(o0[2], o0[3]); ow.z = cvt_pk_bf16(o0[4], o0[5]); ow.w = cvt_pk_bf16(o0[6], o0[7]);
            *(u32x4*)(MIX + (size_t)row0 * D + 512 + 8 * lane) = ow;
            ow.x = cvt_pk_bf16(o1[0], o1[1]); ow.y = cvt_pk_bf16(o1[2], o1[3]); ow.z = cvt_pk_bf16(o1[4], o1[5]); ow.w = cvt_pk_bf16(o1[6], o1[7]);
            *(u32x4*)(MIX + (size_t)(row0 + 1) * D + 512 + 8 * lane) = ow;
        }
        float g8[8], b8[8];
        { const f32x4 ga_ = *(const f32x4*)(lng + 8 * lane), gb_ = *(const f32x4*)(lng + 8 * lane + 4), ba = *(const f32x4*)(lnb + 8 * lane), bb = *(const f32x4*)(lnb + 8 * lane + 4);
#pragma unroll
          for (int j = 0; j < 4; ++j) { g8[j] = ga_[j]; g8[4 + j] = gb_[j]; b8[j] = ba[j]; b8[4 + j] = bb[j]; } }
#pragma unroll
        for (int hb = 0; hb < 2; ++hb) {
            float s[8], q[8];
#pragma unroll
            for (int r8 = 0; r8 < 8; ++r8) { float v[8]; unpack8(vraw[8 * hb + r8], v);
                s[r8] = ((v[0] + v[1]) + (v[2] + v[3])) + ((v[4] + v[5]) + (v[6] + v[7]));
                q[r8] = ((v[0] * v[0] + v[1] * v[1]) + (v[2] * v[2] + v[3] * v[3])) + ((v[4] * v[4] + v[5] * v[5]) + (v[6] * v[6] + v[7] * v[7])); }
#pragma unroll
            for (int o = 1; o < 64; o <<= 1) {
                float ts[8], tq[8];
#pragma unroll
                for (int r8 = 0; r8 < 8; ++r8) { ts[r8] = shfl_xor_l(s[r8], o, lane); tq[r8] = shfl_xor_l(q[r8], o, lane); }
#pragma unroll
                for (int r8 = 0; r8 < 8; ++r8) { s[r8] += ts[r8]; q[r8] += tq[r8]; }
            }
#pragma unroll
            for (int r8 = 0; r8 < 8; ++r8) {
                const int rr = 8 * hb + r8, r = 16 * wave + rr;
                float v[8]; unpack8(vraw[rr], v);
                const float mu = s[r8] * (1.0f / 512.0f);
                const float rstd = __builtin_amdgcn_rsqf(fmaxf(q[r8] * (1.0f / 512.0f) - mu * mu, 0.f) + 1e-6f);
#pragma unroll
                for (int j = 0; j < 8; ++j) v[j] = (v[j] - mu) * rstd * g8[j] + b8[j];
                u32x4 ow; ow.x = cvt_pk_bf16(v[0], v[1]); ow.y = cvt_pk_bf16(v[2], v[3]); ow.z = cvt_pk_bf16(v[4], v[5]); ow.w = cvt_pk_bf16(v[6], v[7]);
                *(LAS u32x4*)(lds + r * 1024 + 16 * (lane ^ (((r >> 3) & 3) << 1))) = ow;
            }
            asm volatile("" ::: "memory");
        }
        u32x4 ga[16];
#pragma unroll
        for (int rr = 0; rr < 16; ++rr) ga[rr] = *(const u32x4*)(GA + (size_t)(rb + rr) * 512 + 8 * lane);
        __syncthreads();
        {
            const int i = lane & 15, q = lane >> 4;
            const int tbase = (8 * q + (i >> 2)) * 1024 + 32 * (wave ^ q) + 8 * (i & 3);
#pragma unroll 1
            for (int h = 0; h < 4; ++h) {
                bf16x8 af[4];
#pragma unroll
                for (int ks = 0; ks < 4; ++ks) {
                    const s16x4 lo = __builtin_amdgcn_ds_read_tr16_b64_v4i16((LAS s16x4*)(lds + tbase + 256 * h + 32768 * ks));
                    const s16x4 hi = __builtin_amdgcn_ds_read_tr16_b64_v4i16((LAS s16x4*)(lds + tbase + 256 * h + 32768 * ks + 4096));
                    af[ks] = (bf16x8){lo[0], lo[1], lo[2], lo[3], hi[0], hi[1], hi[2], hi[3]};
                }
                asm volatile("s_waitcnt lgkmcnt(0)" ::: "memory");
                const bf16* wmh = WM + (size_t)h * 128 * 128;
                bf16x8 wf[8][4]; float bias[8];
#pragma unroll
                for (int tb = 0; tb < 8; ++tb) {
#pragma unroll
                    for (int ks = 0; ks < 4; ++ks) if (ks <= tb / 2) wf[tb][ks] = *(const bf16x8*)(wmh + (16 * tb + i) * 128 + 32 * ks + 8 * q);
                    bias[tb] = bs[h * 128 + 16 * tb + i];
                }
                asm volatile("" ::: "memory");
#pragma unroll
                for (int tb = 0; tb < 8; ++tb) {
                    f32x4 acc = (f32x4){0.f, 0.f, 0.f, 0.f};
                    const int t = 16 * tb + i;
#pragma unroll
                    for (int ks = 0; ks < 4; ++ks) if (ks <= tb / 2) acc = __builtin_amdgcn_mfma_f32_16x16x32_bf16(af[ks], wf[tb][ks], acc, 0, 0, 0);
                    u32x2 ow; ow.x = cvt_pk_bf16(acc[0] + bias[tb], acc[1] + bias[tb]); ow.y = cvt_pk_bf16(acc[2] + bias[tb], acc[3] + bias[tb]);
                    *(LAS u32x2*)(lds + t * 1024 + 2 * ((128 * h + 16 * wave + 4 * q) ^ (((t >> 3) & 3) << 4))) = ow;
                }
            }
        }
        __syncthreads();
#pragma unroll
        for (int hb = 0; hb < 2; ++hb) {
            u32x4 mxw[8];
#pragma unroll
            for (int r8 = 0; r8 < 8; ++r8) { const int r = 16 * wave + 8 * hb + r8; mxw[r8] = *(const LAS u32x4*)(lds + r * 1024 + 16 * (lane ^ (((r >> 3) & 3) << 1))); }
#pragma unroll
            for (int r8 = 0; r8 < 8; ++r8) {
                const int rr = 8 * hb + r8, r = 16 * wave + rr;
                float mx[8], gg[8];
                unpack8(mxw[r8], mx); unpack8(ga[rr], gg);
                u32x4 ow; ow.x = cvt_pk_bf16(gg[0] * mx[0], gg[1] * mx[1]); ow.y = cvt_pk_bf16(gg[2] * mx[2], gg[3] * mx[3]); ow.z = cvt_pk_bf16(gg[4] * mx[4], gg[5] * mx[5]); ow.w = cvt_pk_bf16(gg[6] * mx[6], gg[7] * mx[7]);
                *(u32x4*)(MIX + (size_t)(row0 + r) * D + 8 * lane) = ow;
            }
        }
        __syncthreads();
    }
}

__device__ __forceinline__ void final_phase(const bf16* XB, const float* ssq, const float* g, float* out, int row_base, int wave, int lane) {
    f32x4 gv[4];
#pragma unroll
    for (int j = 0; j < 2; ++j) { gv[2 * j] = *(const f32x4*)(g + 512 * j + 8 * lane); gv[2 * j + 1] = *(const f32x4*)(g + 512 * j + 8 * lane + 4); }
    for (int m0 = row_base + wave * 32; m0 < row_base + wave * 32 + 32; m0 += 4) {
        float s[4]; u32x4 w[4][2];
#pragma unroll
        for (int k = 0; k < 4; ++k) { const int m = m0 + k; s[k] = ssq[(size_t)m * 16 + (lane & 15)];
            w[k][0] = *(const u32x4*)(XB + (size_t)m * D + 8 * lane); w[k][1] = *(const u32x4*)(XB + (size_t)m * D + 512 + 8 * lane); }
#pragma unroll
        for (int o = 1; o < 16; o <<= 1) { float ts[4];
#pragma unroll
            for (int k = 0; k < 4; ++k) ts[k] = shfl_xor_l(s[k], o, lane);
#pragma unroll
            for (int k = 0; k < 4; ++k) s[k] += ts[k]; }
#pragma unroll
        for (int k = 0; k < 4; ++k) {
            const int m = m0 + k;
            const float rs = __builtin_amdgcn_rsqf(s[k] * (1.0f / 1024.0f) + 1e-6f);
#pragma unroll
            for (int j = 0; j < 2; ++j) {
                const u32x4 q = w[k][j];
                const f32x4 a = (f32x4){bf_lo(q.x), bf_hi(q.x), bf_lo(q.y), bf_hi(q.y)}, b = (f32x4){bf_lo(q.z), bf_hi(q.z), bf_lo(q.w), bf_hi(q.w)};
                float* o = out + (size_t)m * D + 512 * j + 8 * lane;
                *(f32x4*)o = a * rs * gv[2 * j]; *(f32x4*)(o + 4) = b * rs * gv[2 * j + 1];
            }
        }
    }
}

__device__ __forceinline__ unsigned char* opaque_ptr(unsigned char* p) { __attribute__((address_space(1))) unsigned char* g = (__attribute__((address_space(1))) unsigned char*)p; asm volatile("" : "+s"(g)); return (unsigned char*)g; }
__device__ __forceinline__ int opaque_int(int v) { asm volatile("" : "+s"(v)); return v; }
__device__ __forceinline__ void group_wait(unsigned* cnt, unsigned target) {
    unsigned sp = 0;
    while (__hip_atomic_load(cnt, __ATOMIC_RELAXED, __HIP_MEMORY_SCOPE_AGENT) < target) { __builtin_amdgcn_s_sleep(1); if (++sp > (1u << 24)) break; }
}
__device__ __forceinline__ void group_barrier(unsigned* cnt, unsigned target, int same_xcc, unsigned* cnt2 = nullptr, unsigned target2 = 0u) {
    asm volatile("s_waitcnt vmcnt(0)" ::: "memory");
    __syncthreads();
    if (threadIdx.x == 0) {
        if (!same_xcc) { __builtin_amdgcn_fence(__ATOMIC_RELEASE, "agent"); asm volatile("s_waitcnt vmcnt(0)" ::: "memory"); }
        (void)__hip_atomic_fetch_add(cnt, 1u, __ATOMIC_RELAXED, __HIP_MEMORY_SCOPE_AGENT);
        group_wait(cnt, target);
        if (cnt2) group_wait(cnt2, target2);
        __builtin_amdgcn_fence(__ATOMIC_ACQUIRE, "agent");
        asm volatile("s_waitcnt vmcnt(0)" ::: "memory");
    }
    __syncthreads();
}
__device__ __forceinline__ void rstd_cache(LAS float* RS, const float* ssq, int c, int wave, int lane, LAS float* CWL = nullptr, const float* cw = nullptr) {
    const int tid = wave * 64 + lane;
    if (CWL && tid < 384) *(LAS f32x4*)(CWL + 4 * tid) = *(const f32x4*)(cw + 4 * tid);
#pragma unroll
    for (int k = 0; k < 2; ++k) {
        const int idx = tid + 512 * k, g = idx >> 8, r = idx & 255, pm = ((c & 7) * 4 + g) * 8 + ((c >> 3) & 7);
        const f32x4* p = (const f32x4*)(ssq + ((size_t)pm * 256 + r) * 16);
        const f32x4 a = p[0], b = p[1], cc = p[2], d = p[3];
        const float s = (((a[0] + a[1]) + (a[2] + a[3])) + ((b[0] + b[1]) + (b[2] + b[3]))) + (((cc[0] + cc[1]) + (cc[2] + cc[3])) + ((d[0] + d[1]) + (d[2] + d[3])));
        RS[idx] = __builtin_amdgcn_rsqf(s * (1.0f / 1024.0f) + 1e-6f);
    }
    __syncthreads();
}
#define XCD_BAR() do { XcdBarrier b2_ = bar; b2_.bar = (unsigned*)opaque_ptr((unsigned char*)bar.bar); b2_.x = (unsigned)opaque_int((int)bar.x); xcd_barrier(b2_); } while (0)
__global__ void __launch_bounds__(NTHREADS, 2) fwd_megakernel(Args a) {
    extern __shared__ __attribute__((aligned(16))) unsigned char lds_raw[];
    LAS unsigned char* lds = (LAS unsigned char*)lds_raw;
    cg::grid_group grid = cg::this_grid();
    const int wave = __builtin_amdgcn_readfirstlane(threadIdx.x >> 6);
    const int G = gridDim.x, bid = blockIdx.x;
    volatile LAS unsigned* MISC = (volatile LAS unsigned*)(lds + RING_BYTES + 512);
    if (threadIdx.x < 16) MISC[threadIdx.x] = 0u;
    __syncthreads();

#pragma unroll 1
    for (int rep = 0; rep < REP_PRO; ++rep)
    prologue(a, lds, G, bid, wave, fresh_lane());
    const XcdBarrier bar = xcd_barrier_post((unsigned*)(a.ws + WS_CTL), MISC + 8);
    if (threadIdx.x == 0) __hip_atomic_store((unsigned*)(a.ws + WS_CTL + 32768) + bid, bar.x + 1u, __ATOMIC_RELAXED, __HIP_MEMORY_SCOPE_AGENT);
    if (G > 100000) grid.sync();
    XCD_BAR();
    const int grp = bid & 63, tile_j = (bid >> 3) & 7, tile_k = bid >> 6, my_tile = ((bid & 7) * 4 + tile_k) * 8 + tile_j;
    const int halo_grp = tile_j > 0 ? grp - 8 : (tile_k > 0 ? (bid & 7) + 56 : -1);
    unsigned nbar = 0u;
    int same_xcc;
    { const unsigned* xt = (const unsigned*)(a.ws + WS_CTL + 32768); const unsigned mine = bar.x + 1u; unsigned ok = 1u;
#pragma unroll
      for (int k = 0; k < 4; ++k) { ok &= (__hip_atomic_load(xt + grp + 64 * k, __ATOMIC_RELAXED, __HIP_MEMORY_SCOPE_AGENT) == mine) ? 1u : 0u;
          if (halo_grp >= 0) ok &= (__hip_atomic_load(xt + halo_grp + 64 * k, __ATOMIC_RELAXED, __HIP_MEMORY_SCOPE_AGENT) == mine) ? 1u : 0u; }
      same_xcc = __builtin_amdgcn_readfirstlane((int)ok); }
#define GROUP_BAR() do { unsigned* gc_ = (unsigned*)opaque_ptr(a.ws + WS_CTL + 16384); ++nbar; group_barrier(gc_ + 64 * grp, 4u * nbar, same_xcc); } while (0)
#pragma unroll 1
    for (int l = 0; l < DEPTH; ++l) {
#pragma unroll 1
        for (int rep = 0; rep < REP_G1; ++rep)
        {
            unsigned char* ws = opaque_ptr(a.ws);
            rstd_cache((LAS float*)(lds + RING_BYTES + 1024), (const float*)(ws + WS_SSQA), bid, wave, fresh_lane(), (LAS float*)(lds + RING_BYTES + 7168), a.in[8] + l * 512 * 3);
            pg8::Gemm g{(const bf16*)(ws + WS_XB0), (const bf16*)(ws + WS_WIN) + (size_t)l * PW * D, M, PW, D}; pg8::StaticOrder S; S.init(M, PW, G, opaque_int(bid));
            bf16* VV = (bf16*)(ws + WS_PROJ); float* HX = (float*)(ws + WS_HX) + (size_t)l * (3 * 256 * 2 * 512);
            pg8::EpiProj E{VV, VV + (size_t)M * 512, (bf16*)(ws + WS_MIX), (const LAS float*)(lds + RING_BYTES + 1024), (const LAS float*)(lds + RING_BYTES + 7168), (LAS float*)(lds + RING_BYTES + 5120), HX, HX + 256 * 2 * 512, HX + 2 * 256 * 2 * 512};
            pg8::gemm_phase<pg8::EpiProj, pg8::StaticOrder, true, true>(lds, g, S, E, opaque_int(wave));
        }
#if defined(PROBE_G1NULL)
        {
            unsigned char* ws = opaque_ptr(a.ws);
            pg8::Gemm g{(const bf16*)(ws + WS_XB0), (const bf16*)(ws + WS_WIN) + (size_t)l * PW * D, M, PW, D}; pg8::StaticOrder S; S.init(M, PW, G, opaque_int(bid));
            pg8::EpiNull E{(float*)(ws + WS_SSQB)};
            pg8::gemm_phase<pg8::EpiNull, pg8::StaticOrder, true, true>(lds, g, S, E, opaque_int(wave));
        }
#endif
#if defined(PROBE_G2NULL)
        {
            unsigned char* ws = opaque_ptr(a.ws);
            pg8::Gemm g{(const bf16*)(ws + WS_XB0), (const bf16*)(ws + WS_WG) + (size_t)l * D * D, M, D, D}; pg8::StaticOrder S; S.init(M, D, G, opaque_int(bid));
            pg8::EpiNull E{(float*)(ws + WS_SSQB)};
            pg8::gemm_phase<pg8::EpiNull, pg8::StaticOrder, true, true>(lds, g, S, E, opaque_int(wave));
        }
#endif
        { unsigned* gc_ = (unsigned*)opaque_ptr(a.ws + WS_CTL + 16384); ++nbar;
          group_barrier(gc_ + 64 * grp, 4u * nbar, same_xcc, halo_grp >= 0 ? gc_ + 64 * halo_grp : nullptr, 4u * (4u * (unsigned)l + 1u)); }
#pragma unroll 1
        for (int rep = 0; rep < REP_MIX; ++rep)
        {
            unsigned char* ws = opaque_ptr(a.ws);
            const bf16* VV = (const bf16*)(ws + WS_PROJ); const float* HX = (const float*)(ws + WS_HX) + (size_t)l * (3 * 256 * 2 * 512);
            mixer_phase(lds, VV, VV + (size_t)M * 512, HX, HX + 256 * 2 * 512, HX + 2 * 256 * 2 * 512, (bf16*)(ws + WS_MIX),
                        (const bf16*)(ws + WS_WM) + (size_t)l * 4 * 128 * 128, a.in[4] + l * 512, a.in[5] + l * 512, a.in[7] + l * 512, a.in[8] + l * 512 * 3, 2 * my_tile, wave, fresh_lane());
            p_convert_tile(a.in[1] + ((size_t)l * M + (size_t)my_tile * 256) * PLE, (bf16*)(ws + WS_PB) + ((size_t)l * M + (size_t)my_tile * 256) * PLE, wave, fresh_lane());
        }
        GROUP_BAR();
        {
            const int par = (bid >> 3) & 1;
#pragma unroll 1
            for (int step = 0; step < 2; ++step) {
                if ((step ^ par) == 0) {
#pragma unroll 1
                for (int rep = 0; rep < REP_G2; ++rep)
                {
                    unsigned char* ws = opaque_ptr(a.ws);
                    pg8::Gemm g{(const bf16*)(ws + WS_MIX), (const bf16*)(ws + WS_WOUT) + (size_t)l * D * D, M, D, D}; pg8::StaticOrder S; S.init(M, D, G, opaque_int(bid));
                    pg8::EpiResid<false> E{nullptr, (const bf16*)(ws + WS_XB0), (bf16*)(ws + WS_XB1), (float*)(ws + WS_SSQB)};
                    pg8::gemm_phase<pg8::EpiResid<false>, pg8::StaticOrder, true, true>(lds, g, S, E, opaque_int(wave));
                }
                } else {
#pragma unroll 1
                for (int rep = 0; rep < REP_GP; ++rep)
                {
                    unsigned char* ws = opaque_ptr(a.ws);
                    pg8::Gemm g{(const bf16*)(ws + WS_PB) + (size_t)l * M * PLE, (const bf16*)(ws + WS_WP) + (size_t)l * D * PLE, M, D, PLE}; pg8::StaticOrder S; S.init(M, D, G, opaque_int(bid));
                    pg8::EpiPlainBf16 E{(bf16*)(ws + WS_PP), D};
                    pg8::gemm_phase<pg8::EpiPlainBf16, pg8::StaticOrder, true, true>(lds, g, S, E, opaque_int(wave));
                }
                }
            }
        }
        GROUP_BAR();
#pragma unroll 1
        for (int rep = 0; rep < REP_G3; ++rep)
        {
            unsigned char* ws = opaque_ptr(a.ws);
            pg8::Gemm g{(const bf16*)(ws + WS_XB1), (const bf16*)(ws + WS_WG) + (size_t)l * D * D, M, D, D}; pg8::StaticOrder S; S.init(M, D, G, opaque_int(bid));
            rstd_cache((LAS float*)(lds + RING_BYTES + 1024), (const float*)(ws + WS_SSQB), bid, wave, fresh_lane());
            pg8::EpiGate E{(const bf16*)(ws + WS_XB1), (const bf16*)(ws + WS_PP), (bf16*)(ws + WS_XB0), (const LAS float*)(lds + RING_BYTES + 1024), (float*)(ws + WS_SSQA)};
            pg8::gemm_phase<pg8::EpiGate, pg8::StaticOrder, true, true>(lds, g, S, E, opaque_int(wave));
        }
        GROUP_BAR();
    }
    final_phase((const bf16*)(a.ws + WS_XB0), (const float*)(a.ws + WS_SSQA), a.in[13], a.out, my_tile * 256, wave, fresh_lane());
}

extern "C" void kernel_launch(void* const* d_in, const int* in_sizes, int n_in, void* d_out, int out_size, void* d_ws, size_t ws_size, hipStream_t stream) {
    static int grid = 0;
    if (grid == 0) {
        if (n_in != 14 || out_size != M * D || ws_size < WS_END) { fprintf(stderr, "kernel_launch: unexpected shapes: n_in %d out %d ws %zu\n", n_in, out_size, ws_size); grid = -1; return; }
        int dev = 0, cus = 0, per_cu = 0;
        hipGetDevice(&dev); hipDeviceGetAttribute(&cus, hipDeviceAttributeMultiprocessorCount, dev);
        hipFuncSetAttribute((const void*)fwd_megakernel, hipFuncAttributeMaxDynamicSharedMemorySize, LDS_BYTES);
        hipOccupancyMaxActiveBlocksPerMultiprocessor(&per_cu, (const void*)fwd_megakernel, NTHREADS, LDS_BYTES);
        (void)hipGetLastError();
        if (per_cu < 1) per_cu = 1;
        grid = 256;
        fprintf(stderr, "kernel_launch: cus %d per_cu %d grid %d\n", cus, per_cu, grid);
    }
    if (grid < 0) return;
    (void)hipMemsetAsync((char*)d_ws + WS_CTL, 0, 32768 + 1024, stream);
    Args a{};
    for (int i = 0; i < 14; ++i) a.in[i] = (const float*)d_in[i];
    a.out = (float*)d_out; a.ws = (unsigned char*)d_ws;
    void* args[] = {&a};
    hipError_t e = hipLaunchCooperativeKernel((const void*)fwd_megakernel, dim3(grid), dim3(NTHREADS), args, LDS_BYTES, stream);
    if (e != hipSuccess) fprintf(stderr, "cooperative launch failed: %s (grid %d)\n", hipGetErrorString(e), grid);
}
```

```cpp
#include <hip/hip_runtime.h>
#include <hip/hip_cooperative_groups.h>
#include <cstdio>
#include <cstdint>
namespace cg = cooperative_groups;
namespace pg8 {
#define PG8_LAS __attribute__((address_space(3)))
typedef unsigned short bf16_t;
typedef short bf16x8 __attribute__((ext_vector_type(8)));
typedef float f32x4 __attribute__((ext_vector_type(4)));
typedef unsigned u32x4 __attribute__((ext_vector_type(4)));
constexpr int BM = 256, BK = 64, HALF = 128, HTB = HALF * BK * 2  , STAGE_BYTES = 8 * HTB, NXCD = 8, WGM = 8;

__host__ __device__ __forceinline__ int lds_byte(int r, int c) { const int st = (r >> 4) * 2 + (c >> 5), rr = r & 15, cc = c & 31, ob = rr * 64 + cc * 2; return st * 1024 + (ob ^ (((ob >> 9) & 1) << 5)); }
__host__ __device__ __forceinline__ void stage_rc(int b, int& R, int& C) { const int st = b / 1024, sb = b % 1024, swz = sb ^ (((sb >> 9) & 1) << 5); R = (st >> 1) * 16 + swz / 64; C = (st & 1) * 32 + (swz % 64) / 2; }
__host__ __device__ __forceinline__ int perm32(int rho) { const int n = rho >> 4, i = rho & 15; return 8 * (i >> 2) + 4 * n + (i & 3); }

struct Unit { int pm, pn; };
struct Gemm { const bf16_t* A; const bf16_t* Bt; int M, N, K; int ablk = 0; };

struct StaticOrder {
    int nM, nN, nwg, G, c;
    __host__ __device__ void init(int M, int N, int G_, int c_) { nM = M / BM; nN = N / BM; nwg = nM * nN; G = G_; c = c_; }
    __host__ __device__ bool next(int i, Unit& u) const {
        const long L = (long)i * G + c; if (L >= nwg) return false;
        int wgid = (int)L; { const int q = nwg / NXCD, r = nwg % NXCD, xcd = wgid % NXCD, off = wgid / NXCD; wgid = (xcd < r ? xcd * (q + 1) : r * (q + 1) + (xcd - r) * q) + off; }
        const int nig = WGM * nN, gid = wgid / nig, fm = gid * WGM, gsz = (nM - fm) < WGM ? (nM - fm) : WGM;
        u.pm = fm + ((wgid % nig) % gsz); u.pn = (wgid % nig) / gsz; return true;
    }
    __device__ __forceinline__ void a_ready(const Unit&) const {}
    __device__ __forceinline__ void done(const Unit&) const {}
};

__device__ __forceinline__ unsigned cvt_pk_bf16(float lo, float hi) { unsigned r; asm volatile("v_cvt_pk_bf16_f32 %0, %1, %2" : "=v"(r) : "v"(lo), "v"(hi)); return r; }
typedef float f32x2 __attribute__((ext_vector_type(2)));
typedef unsigned u32x2 __attribute__((ext_vector_type(2)));
__device__ __forceinline__ float row_rstd16(const float* ssq, int r) {
    const f32x4* p = (const f32x4*)(ssq + (size_t)r * 16);
    const f32x4 a = p[0], b = p[1], c = p[2], d = p[3];
    const float s = (((a[0] + a[1]) + (a[2] + a[3])) + ((b[0] + b[1]) + (b[2] + b[3]))) + (((c[0] + c[1]) + (c[2] + c[3])) + ((d[0] + d[1]) + (d[2] + d[3])));
    return __builtin_amdgcn_rsqf(s * (1.0f / 1024.0f) + 1e-6f);
}
__device__ __forceinline__ float sigmoid_f(float v) { return __builtin_amdgcn_rcpf(1.0f + __builtin_amdgcn_exp2f(v * -1.4426950408889634f)); }
__device__ __forceinline__ float shfl_xor_l(float v, int mask, int lane) { return __int_as_float(__builtin_amdgcn_ds_bpermute((lane ^ mask) << 2, __float_as_int(v))); }
__device__ __forceinline__ float bf_lo(unsigned w) { return __uint_as_float(w << 16); }
__device__ __forceinline__ float bf_hi(unsigned w) { return __uint_as_float(w & 0xffff0000u); }

struct EpiPlainBf16 {
    static constexpr bool PERM = true, AFTER_DRAIN = false;
    bf16_t* O; int ldc;
    __device__ __forceinline__ void operator()(const f32x4 (&acc)[2][2][4][2], const Unit& u, int wr, int wc, int fr, int fq) const {
        const unsigned boff = (unsigned)((((u.pm * 4 + u.pn) * 8 + wr * 4 + wc) * 16) * 64 + fq * 16 + fr) * 16u;
#pragma unroll
        for (int ai = 0; ai < 2; ++ai)
#pragma unroll
            for (int m = 0; m < 4; ++m)
#pragma unroll
                for (int bj = 0; bj < 2; ++bj) {
                    const f32x4 v0 = acc[ai][bj][m][0], v1 = acc[ai][bj][m][1];
                    u32x4 w; w.x = cvt_pk_bf16(v0[0], v0[1]); w.y = cvt_pk_bf16(v0[2], v0[3]); w.z = cvt_pk_bf16(v1[0], v1[1]); w.w = cvt_pk_bf16(v1[2], v1[3]);
                    *(u32x4*)((char*)O + (boff + (unsigned)(((ai * 4 + m) * 2 + bj) * 1024))) = w;
                }
    }
};
struct EpiProj {
    static constexpr bool PERM = true, AFTER_DRAIN = false;
    bf16_t* V; bf16_t* GA; bf16_t* MIXB; const PG8_LAS float* RS; const PG8_LAS float* CWL; PG8_LAS float* HALO; float* HXL; float* HX0; float* HG0;
    __device__ __forceinline__ void operator()(const f32x4 (&acc)[2][2][4][2], const Unit& u, int wr, int wc, int fr, int fq) const {
        const int row0 = u.pm * BM + wr * 64 + fr;
        float rs[2][4];
        const PG8_LAS float* rsp = RS + ((u.pm >> 3) & 3) * 256 + wr * 64 + fr;
#pragma unroll
        for (int ai = 0; ai < 2; ++ai)
#pragma unroll
            for (int m = 0; m < 4; ++m) rs[ai][m] = rsp[ai * HALF + m * 16];
        if (u.pn < 2) {
#pragma unroll
            for (int ai = 0; ai < 2; ++ai)
#pragma unroll
                for (int m = 0; m < 4; ++m) {
                    bf16_t* rowp = V + (size_t)(row0 + ai * HALF + m * 16) * 512 + u.pn * 256 + wc * 32 + 8 * fq; const float sc = rs[ai][m];
#pragma unroll
                    for (int bj = 0; bj < 2; ++bj) {
                        const f32x4 v0 = acc[ai][bj][m][0] * sc, v1 = acc[ai][bj][m][1] * sc;
                        u32x4 w; w.x = cvt_pk_bf16(v0[0], v0[1]); w.y = cvt_pk_bf16(v0[2], v0[3]); w.z = cvt_pk_bf16(v1[0], v1[1]); w.w = cvt_pk_bf16(v1[2], v1[3]);
                        *(u32x4*)(rowp + bj * HALF) = w;
                    }
                }
        } else if (u.pn < 6) {
#pragma unroll
            for (int ai = 0; ai < 2; ++ai)
#pragma unroll
                for (int m = 0; m < 4; ++m) {
                    bf16_t* rowp = GA + (size_t)(row0 + ai * HALF + m * 16) * 512 + (u.pn - 2) * 128 + wc * 32 + 8 * fq; const float sc = rs[ai][m];
                    float o[8];
#pragma unroll
                    for (int n = 0; n < 2; ++n)
#pragma unroll
                        for (int j = 0; j < 4; ++j) { const float uu = acc[ai][0][m][n][j] * sc, zz = acc[ai][1][m][n][j] * sc; o[4 * n + j] = uu * zz * sigmoid_f(zz); }
                    u32x4 w; w.x = cvt_pk_bf16(o[0], o[1]); w.y = cvt_pk_bf16(o[2], o[3]); w.z = cvt_pk_bf16(o[4], o[5]); w.w = cvt_pk_bf16(o[6], o[7]);
                    *(u32x4*)rowp = w;
                }
        } else {
            const int ch0 = (u.pn - 6) * 64 + wc * 16 + 4 * fq, lane = fq * 16 + fr;
            float xc[2][4][4], gz[2][4][4];
#pragma unroll
            for (int ai = 0; ai < 2; ++ai)
#pragma unroll
                for (int m = 0; m < 4; ++m) { const float sc = rs[ai][m];
#pragma unroll
                    for (int j = 0; j < 4; ++j) { const float hh = acc[ai][0][m][0][j] * sc, bb = acc[ai][0][m][1][j] * sc, cc = acc[ai][1][m][0][j] * sc, zz = acc[ai][1][m][1][j] * sc;
                        xc[ai][m][j] = cc * hh; gz[ai][m][j] = bb * zz * sigmoid_f(zz); } }
            float tw[12];
            { const PG8_LAS f32x4* cwp = (const PG8_LAS f32x4*)(CWL + 3 * ch0); const f32x4 c0 = cwp[0], c1 = cwp[1], c2 = cwp[2];
#pragma unroll
              for (int k = 0; k < 4; ++k) { tw[k] = c0[k]; tw[4 + k] = c1[k]; tw[8 + k] = c2[k]; } }
            if (fr >= 14) {
#pragma unroll
                for (int ai = 0; ai < 2; ++ai) *(PG8_LAS f32x4*)(HALO + (((ai * 2 + wr) * 2 + (fr - 14)) * 64 + wc * 16 + 4 * fq)) = (f32x4){xc[ai][3][0], xc[ai][3][1], xc[ai][3][2], xc[ai][3][3]};
                if (wr == 1) *(f32x4*)(HXL + ((size_t)u.pm * 2 + (fr - 14)) * 512 + ch0) = (f32x4){xc[1][3][0], xc[1][3][1], xc[1][3][2], xc[1][3][3]};
            }
            if (wr == 0 && fr < 2) {
                *(f32x4*)(HX0 + ((size_t)u.pm * 2 + fr) * 512 + ch0) = (f32x4){xc[0][0][0], xc[0][0][1], xc[0][0][2], xc[0][0][3]};
                *(f32x4*)(HG0 + ((size_t)u.pm * 2 + fr) * 512 + ch0) = (f32x4){gz[0][0][0], gz[0][0][1], gz[0][0][2], gz[0][0][3]};
            }
            asm volatile("s_waitcnt lgkmcnt(0)" ::: "memory"); __builtin_amdgcn_s_barrier(); asm volatile("" ::: "memory");
#pragma unroll
            for (int ai = 0; ai < 2; ++ai) {
                f32x4 p1 = (f32x4){0.f, 0.f, 0.f, 0.f}, p2 = p1;
                if (wr == 1) { p2 = *(const PG8_LAS f32x4*)(HALO + (((ai * 2 + 0) * 2 + 0) * 64 + wc * 16 + 4 * fq)); p1 = *(const PG8_LAS f32x4*)(HALO + (((ai * 2 + 0) * 2 + 1) * 64 + wc * 16 + 4 * fq)); }
                else if (ai == 1) { p2 = *(const PG8_LAS f32x4*)(HALO + (((0 * 2 + 1) * 2 + 0) * 64 + wc * 16 + 4 * fq)); p1 = *(const PG8_LAS f32x4*)(HALO + (((0 * 2 + 1) * 2 + 1) * 64 + wc * 16 + 4 * fq)); }
                float r1p[4], r2p[4];
#pragma unroll
                for (int j = 0; j < 4; ++j) { r1p[j] = p1[j]; r2p[j] = (fr == 1) ? p1[j] : p2[j]; }
#pragma unroll
                for (int m = 0; m < 4; ++m) {
                    float o[4];
#pragma unroll
                    for (int j = 0; j < 4; ++j) {
                        const float cur = xc[ai][m][j];
                        const float r1c = __int_as_float(__builtin_amdgcn_update_dpp(0, __float_as_int(cur), 0x121  , 0xf, 0xf, false)), r2c = __int_as_float(__builtin_amdgcn_update_dpp(0, __float_as_int(cur), 0x122  , 0xf, 0xf, false));
                        const float x1 = (fr >= 1) ? r1c : r1p[j], x2 = (fr >= 2) ? r2c : r2p[j];
                        o[j] = gz[ai][m][j] * (tw[3 * j] * x2 + tw[3 * j + 1] * x1 + tw[3 * j + 2] * cur);
                        r1p[j] = r1c; r2p[j] = r2c;
                    }
                    u32x2 w; w.x = cvt_pk_bf16(o[0], o[1]); w.y = cvt_pk_bf16(o[2], o[3]);
                    *(u32x2*)(MIXB + (size_t)(row0 + ai * HALF + m * 16) * 1024 + 512 + ch0) = w;
                }
            }
        }
    }
};
template <bool F32IN> struct EpiResid {
    static constexpr bool PERM = true, AFTER_DRAIN = false;
    const float* xin_f; const bf16_t* xin_b; bf16_t* xb; float* ssq_out;
    __device__ __forceinline__ void operator()(const f32x4 (&acc)[2][2][4][2], const Unit& u, int wr, int wc, int fr, int fq) const {
        static_assert(!F32IN, "the batched epilogue reads the bf16 residual");
        const int row0 = u.pm * BM + wr * 64 + fr, col0 = u.pn * BM + wc * 32 + 8 * fq, lane = fq * 16 + fr;
        u32x4 xwv[2][4][2]; float ssum[2][4];
#pragma unroll
        for (int ai = 0; ai < 2; ++ai)
#pragma unroll
            for (int m = 0; m < 4; ++m)
#pragma unroll
                for (int bj = 0; bj < 2; ++bj) xwv[ai][m][bj] = *(const u32x4*)(xin_b + (size_t)(row0 + ai * HALF + m * 16) * 1024 + col0 + bj * HALF);
        asm volatile("" ::: "memory");
#pragma unroll
        for (int ai = 0; ai < 2; ++ai)
#pragma unroll
            for (int m = 0; m < 4; ++m) {
                f32x2 sq = (f32x2){0.f, 0.f};
#pragma unroll
                for (int bj = 0; bj < 2; ++bj) {
                    const unsigned xws[4] = {xwv[ai][m][bj].x, xwv[ai][m][bj].y, xwv[ai][m][bj].z, xwv[ai][m][bj].w};
                    unsigned wout[4];
#pragma unroll
                    for (int h2 = 0; h2 < 4; ++h2) {
                        const f32x4 av = acc[ai][bj][m][h2 >> 1];
                        const f32x2 v = (f32x2){av[2 * (h2 & 1)], av[2 * (h2 & 1) + 1]} + (f32x2){bf_lo(xws[h2]), bf_hi(xws[h2])};
                        sq = v * v + sq;
                        wout[h2] = cvt_pk_bf16(v.x, v.y);
                    }
                    u32x4 w; w.x = wout[0]; w.y = wout[1]; w.z = wout[2]; w.w = wout[3];
                    *(u32x4*)((char*)xb + ((size_t)((u.pm * 16 + ai * 8 + wr * 4 + m) * 32 + u.pn * 8 + bj * 4 + wc) * 1024 + (unsigned)(fq * 256 + fr * 16))) = w;
                }
                ssum[ai][m] = sq.x + sq.y;
            }
        asm volatile("" ::: "memory");
        float t16[2][4];
#pragma unroll
        for (int ai = 0; ai < 2; ++ai)
#pragma unroll
            for (int m = 0; m < 4; ++m) t16[ai][m] = shfl_xor_l(ssum[ai][m], 16, lane);
#pragma unroll
        for (int ai = 0; ai < 2; ++ai)
#pragma unroll
            for (int m = 0; m < 4; ++m) ssum[ai][m] += t16[ai][m];
#pragma unroll
        for (int ai = 0; ai < 2; ++ai)
#pragma unroll
            for (int m = 0; m < 4; ++m) t16[ai][m] = shfl_xor_l(ssum[ai][m], 32, lane);
        if (fq == 0) {
#pragma unroll
            for (int ai = 0; ai < 2; ++ai)
#pragma unroll
                for (int m = 0; m < 4; ++m) ssq_out[(size_t)(row0 + ai * HALF + m * 16) * 16 + u.pn * 4 + wc] = ssum[ai][m] + t16[ai][m];
        }
    }
};
struct EpiGate {
    static constexpr bool PERM = true, AFTER_DRAIN = false;
    const bf16_t* xb_in; const bf16_t* pp; bf16_t* xb_out; const PG8_LAS float* RS; float* ssq_out;
    __device__ __forceinline__ void operator()(const f32x4 (&acc)[2][2][4][2], const Unit& u, int wr, int wc, int fr, int fq) const {
        const int row0 = u.pm * BM + wr * 64 + fr, col0 = u.pn * BM + wc * 32 + 8 * fq, lane = fq * 16 + fr;
        const unsigned poff = (unsigned)((((u.pm * 4 + u.pn) * 8 + wr * 4 + wc) * 16) * 64 + fq * 16 + fr) * 16u;
        float cm[2][4], ssum[2][4];
        { const PG8_LAS float* rsp = RS + ((u.pm >> 3) & 3) * 256 + wr * 64 + fr;
#pragma unroll
          for (int ai = 0; ai < 2; ++ai)
#pragma unroll
              for (int m = 0; m < 4; ++m) cm[ai][m] = rsp[ai * HALF + m * 16] * -1.4426950408889634f; }
        u32x4 pwv[2][2][2], xwv[2][2][2];
#define PG8_GATE_LOAD(QQ, BUF) do { _Pragma("unroll") for (int mm = 0; mm < 2; ++mm) _Pragma("unroll") for (int bj = 0; bj < 2; ++bj) { const int ai_ = (QQ) >> 1, m_ = 2 * ((QQ) & 1) + mm; \
            pwv[BUF][mm][bj] = *(const u32x4*)((const char*)pp + (poff + (unsigned)(((ai_ * 4 + m_) * 2 + bj) * 1024))); \
            xwv[BUF][mm][bj] = *(const u32x4*)((const char*)xb_in + ((size_t)((u.pm * 16 + ai_ * 8 + wr * 4 + m_) * 32 + u.pn * 8 + bj * 4 + wc) * 1024 + (unsigned)(fq * 256 + fr * 16))); } } while (0)
        PG8_GATE_LOAD(0, 0); PG8_GATE_LOAD(1, 1);
        asm volatile("" ::: "memory");
#pragma unroll
        for (int qq = 0; qq < 4; ++qq) {
            const int ai = qq >> 1, buf = qq & 1;
            u32x4 wst[2][2]; float sst[2];
#pragma unroll
            for (int mm = 0; mm < 2; ++mm) {
                const int m = 2 * (qq & 1) + mm;
                f32x2 sq = (f32x2){0.f, 0.f};
#pragma unroll
                for (int bj = 0; bj < 2; ++bj) {
                    const unsigned pws[4] = {pwv[buf][mm][bj].x, pwv[buf][mm][bj].y, pwv[buf][mm][bj].z, pwv[buf][mm][bj].w}, xws[4] = {xwv[buf][mm][bj].x, xwv[buf][mm][bj].y, xwv[buf][mm][bj].z, xwv[buf][mm][bj].w};
                    unsigned wout[4];
#pragma unroll
                    for (int h2 = 0; h2 < 4; ++h2) {
                        const f32x4 av = acc[ai][bj][m][h2 >> 1];
                        const f32x2 t = (f32x2){av[2 * (h2 & 1)], av[2 * (h2 & 1) + 1]} * cm[ai][m];
                        f32x2 e2; e2.x = __builtin_amdgcn_exp2f(t.x); e2.y = __builtin_amdgcn_exp2f(t.y);
                        const f32x2 d = e2 + 1.0f;
                        f32x2 sg; sg.x = __builtin_amdgcn_rcpf(d.x); sg.y = __builtin_amdgcn_rcpf(d.y);
                        const f32x2 pf = (f32x2){bf_lo(pws[h2]), bf_hi(pws[h2])}, xf = (f32x2){bf_lo(xws[h2]), bf_hi(xws[h2])};
                        const f32x2 v = sg * pf + xf;
                        sq = v * v + sq;
                        wout[h2] = cvt_pk_bf16(v.x, v.y);
                    }
                    wst[mm][bj].x = wout[0]; wst[mm][bj].y = wout[1]; wst[mm][bj].z = wout[2]; wst[mm][bj].w = wout[3];
                }
                sst[mm] = sq.x + sq.y;
            }
            asm volatile("" ::: "memory");
            if (qq == 0) PG8_GATE_LOAD(2, 0);
            if (qq == 1) PG8_GATE_LOAD(3, 1);
            asm volatile("" ::: "memory");
#pragma unroll
            for (int mm = 0; mm < 2; ++mm) { const int m = 2 * (qq & 1) + mm; ssum[ai][m] = sst[mm];
#pragma unroll
                for (int bj = 0; bj < 2; ++bj) *(u32x4*)(xb_out + (size_t)(row0 + ai * HALF + m * 16) * 1024 + col0 + bj * HALF) = wst[mm][bj]; }
            asm volatile("" ::: "memory");
        }
#undef PG8_GATE_LOAD
        float t16[2][4];
#pragma unroll
        for (int ai = 0; ai < 2; ++ai)
#pragma unroll
            for (int m = 0; m < 4; ++m) t16[ai][m] = shfl_xor_l(ssum[ai][m], 16, lane);
#pragma unroll
        for (int ai = 0; ai < 2; ++ai)
#pragma unroll
            for (int m = 0; m < 4; ++m) ssum[ai][m] += t16[ai][m];
#pragma unroll
        for (int ai = 0; ai < 2; ++ai)
#pragma unroll
            for (int m = 0; m < 4; ++m) t16[ai][m] = shfl_xor_l(ssum[ai][m], 32, lane);
        if (fq == 0) {
#pragma unroll
            for (int ai = 0; ai < 2; ++ai)
#pragma unroll
                for (int m = 0; m < 4; ++m) ssq_out[(size_t)(row0 + ai * HALF + m * 16) * 16 + u.pn * 4 + wc] = ssum[ai][m] + t16[ai][m];
        }
    }
};

struct EpiNull {
    static constexpr bool PERM = true, AFTER_DRAIN = false;
    float* sink;
    __device__ __forceinline__ void operator()(const f32x4 (&acc)[2][2][4][2], const Unit& u, int wr, int wc, int fr, int fq) const {
        float s = 0.f;
#pragma unroll
        for (int ai = 0; ai < 2; ++ai)
#pragma unroll
            for (int bj = 0; bj < 2; ++bj)
#pragma unroll
                for (int m = 0; m < 4; ++m)
#pragma unroll
                    for (int n = 0; n < 2; ++n) s += (acc[ai][bj][m][n][0] + acc[ai][bj][m][n][1]) + (acc[ai][bj][m][n][2] + acc[ai][bj][m][n][3]);
        if (s == 123456.789f) sink[u.pm + fr] = s;
    }
};
template <class Epi, class Sched, bool ALIGN_EPI = false, bool SP2 = false>
__device__ __forceinline__ void gemm_phase(PG8_LAS unsigned char* lds, const Gemm g, const Sched& S, const Epi& E, const int wid_in) {
    int lane_; asm volatile("v_mbcnt_lo_u32_b32 %0, -1, 0\n\tv_mbcnt_hi_u32_b32 %0, -1, %0" : "=v"(lane_));
    const int wid = wid_in, lane = lane_, tid = wid * 64 + lane, wr = wid >> 2, wc = wid & 3, fr = lane & 15, fq = lane >> 4;
    const int K = g.K, nt = K / BK;
    unsigned voffA[2], voffB[2];
#pragma unroll
    for (int i = 0; i < 2; ++i) { int R, C; stage_rc(tid * 16 + i * 8192, R, C); const int Rb = Epi::PERM ? ((R & ~31) + perm32(R & 31)) : R;
        voffA[i] = g.ablk ? (unsigned)(((R >> 4) * 32 + (C >> 5)) * 1024 + ((C >> 3) & 3) * 256 + (R & 15) * 16) : (unsigned)(R * K + C) * 2u; voffB[i] = (unsigned)(Rb * K + C) * 2u; }
    const size_t kstep = (size_t)(BK * 2);
    const size_t kstepA = g.ablk ? (size_t)2048 : kstep;
    const size_t hstep = (size_t)HALF * K * 2;
    const size_t tstep = 2 * hstep;
    const unsigned ldsw = (unsigned)wid * 1024u;
    const int aoff = lds_byte(wr * 64 + fr, fq * 8), boff = lds_byte(wc * 32 + fr, fq * 8);
#define PG8_SA(b, h) (((b) * 2 + (h)) * HTB)
#define PG8_SB(b, h) ((4 + (b) * 2 + (h)) * HTB)
#define PG8_STAGE(bufoff, gbase, voff) do { _Pragma("unroll") for (int _i = 0; _i < 2; ++_i) \
        __builtin_amdgcn_global_load_lds((const unsigned*)((const char*)(gbase) + (voff)[_i]), (PG8_LAS unsigned*)(lds + (bufoff) + ldsw + _i * 8192), 16, 0, 0); } while (0)
#define PG8_LDA(dst, b, h) do { _Pragma("unroll") for (int m = 0; m < 4; ++m) _Pragma("unroll") for (int k = 0; k < 2; ++k) dst[m][k] = *(const PG8_LAS bf16x8*)(lds + PG8_SA(b, h) + aoff + m * 2048 + k * 1024); } while (0)
#define PG8_LDB(dst, b, h) do { _Pragma("unroll") for (int n = 0; n < 2; ++n) _Pragma("unroll") for (int k = 0; k < 2; ++k) dst[n][k] = *(const PG8_LAS bf16x8*)(lds + PG8_SB(b, h) + boff + n * 2048 + k * 1024); } while (0)
#define PG8_MMA(ai, bj, At, Bt) do { __builtin_amdgcn_s_setprio(1); _Pragma("unroll") for (int m = 0; m < 4; ++m) _Pragma("unroll") for (int n = 0; n < 2; ++n) _Pragma("unroll") for (int k = 0; k < 2; ++k) \
        acc[ai][bj][m][n] = __builtin_amdgcn_mfma_f32_16x16x32_bf16(Bt[n][k], At[m][k], acc[ai][bj][m][n], 0, 0, 0); __builtin_amdgcn_s_setprio(0); } while (0)
#define PG8_WAIT_V(n) asm volatile("s_waitcnt vmcnt(" #n ")" ::: "memory")
#define PG8_WAIT_L(n) asm volatile("s_waitcnt lgkmcnt(" #n ")" ::: "memory")
#define PG8_BAR __builtin_amdgcn_s_barrier()
#define PG8_SCHED __builtin_amdgcn_sched_barrier(0)
    Unit cur, nxt; int ui = 0;
    if (!S.next(0, cur)) return;
    f32x4 acc[2][2][4][2];
#pragma unroll
    for (int a = 0; a < 2; ++a)
#pragma unroll
        for (int b = 0; b < 2; ++b)
#pragma unroll
            for (int m = 0; m < 4; ++m)
#pragma unroll
                for (int n = 0; n < 2; ++n) acc[a][b][m][n] = (f32x4){0.f, 0.f, 0.f, 0.f};
    bf16x8 At[4][2], B0[2][2], B1[2][2];
    const char* cA = (const char*)g.A + (size_t)cur.pm * tstep; const char* cB = (const char*)g.Bt + (size_t)cur.pn * tstep;
    S.a_ready(cur);
    if constexpr (SP2) {
        PG8_STAGE(PG8_SB(0, 0), cB, voffB); PG8_STAGE(PG8_SB(0, 1), cB + hstep, voffB); PG8_STAGE(PG8_SA(0, 0), cA, voffA); PG8_STAGE(PG8_SA(0, 1), cA + hstep, voffA);
        if (wr == 1) PG8_BAR;
        PG8_WAIT_V(2); PG8_BAR;
        PG8_STAGE(PG8_SB(1, 0), cB + kstep, voffB); PG8_STAGE(PG8_SA(1, 0), cA + kstepA, voffA); PG8_STAGE(PG8_SB(1, 1), cB + hstep + kstep, voffB);
        PG8_WAIT_V(6); PG8_BAR;
    } else {
        PG8_STAGE(PG8_SB(0, 0), cB, voffB); PG8_STAGE(PG8_SA(0, 0), cA, voffA); PG8_STAGE(PG8_SB(0, 1), cB + hstep, voffB); PG8_STAGE(PG8_SA(0, 1), cA + hstep, voffA);
        if (wr == 1) PG8_BAR;
        PG8_WAIT_V(4); PG8_BAR;
        PG8_STAGE(PG8_SB(1, 0), cB + kstep, voffB); PG8_STAGE(PG8_SA(1, 0), cA + kstepA, voffA); PG8_STAGE(PG8_SB(1, 1), cB + hstep + kstep, voffB);
        PG8_WAIT_V(6); PG8_BAR;
    }
    for (;;) {
        const bool has_next = S.next(ui + 1, nxt);
        const char* nA = has_next ? (const char*)g.A + (size_t)nxt.pm * tstep : cA; const char* nB = has_next ? (const char*)g.Bt + (size_t)nxt.pn * tstep : cB;
        for (int t = 0; t < nt; t += 2) {
            const bool last = (t == nt - 2);
            const char* a1 = cA + (size_t)(t + 1) * kstepA;
            const char* a2 = last ? nA : cA + (size_t)(t + 2) * kstepA; const char* b2 = last ? nB : cB + (size_t)(t + 2) * kstep;
            const char* a3 = a2 + kstepA; const char* b3 = b2 + kstep;
            if (last && has_next) S.a_ready(nxt);
            if constexpr (SP2) {
            PG8_LDB(B0, 0, 0); PG8_LDB(B1, 0, 1); PG8_SCHED; PG8_LDA(At, 0, 0); PG8_STAGE(PG8_SA(1, 1), a1 + hstep, voffA);
            PG8_WAIT_V(8); PG8_WAIT_L(0); PG8_BAR; PG8_MMA(0, 0, At, B0); PG8_MMA(0, 1, At, B1); PG8_BAR; PG8_SCHED;
            PG8_LDA(At, 0, 1); PG8_STAGE(PG8_SB(0, 0), b2, voffB); PG8_STAGE(PG8_SB(0, 1), b2 + hstep, voffB); PG8_STAGE(PG8_SA(0, 0), a2, voffA);
            PG8_WAIT_V(8); PG8_WAIT_L(0); PG8_BAR; PG8_MMA(1, 0, At, B0); PG8_MMA(1, 1, At, B1); PG8_BAR; PG8_SCHED;
            PG8_LDB(B0, 1, 0); PG8_LDB(B1, 1, 1); PG8_SCHED; PG8_LDA(At, 1, 0); PG8_STAGE(PG8_SA(0, 1), a2 + hstep, voffA);
            PG8_WAIT_V(8); PG8_WAIT_L(0); PG8_BAR; PG8_MMA(0, 0, At, B0); PG8_MMA(0, 1, At, B1); PG8_BAR; PG8_SCHED;
            PG8_LDA(At, 1, 1); PG8_STAGE(PG8_SB(1, 0), b3, voffB); PG8_STAGE(PG8_SB(1, 1), b3 + hstep, voffB); PG8_STAGE(PG8_SA(1, 0), a3, voffA);
            PG8_WAIT_V(8); PG8_WAIT_L(0); PG8_BAR; PG8_MMA(1, 0, At, B0); PG8_MMA(1, 1, At, B1); PG8_BAR; PG8_SCHED;
            } else {
            PG8_LDB(B0, 0, 0); PG8_SCHED; PG8_LDA(At, 0, 0); PG8_STAGE(PG8_SA(1, 1), a1 + hstep, voffA);
            PG8_WAIT_L(8); PG8_BAR; PG8_WAIT_L(0); PG8_MMA(0, 0, At, B0); PG8_BAR; PG8_SCHED;
            PG8_LDB(B1, 0, 1); PG8_STAGE(PG8_SB(0, 0), b2, voffB);
            PG8_BAR; PG8_WAIT_L(0); PG8_MMA(0, 1, At, B1); PG8_BAR;
            PG8_LDA(At, 0, 1); PG8_STAGE(PG8_SA(0, 0), a2, voffA);
            PG8_BAR; PG8_WAIT_L(0); PG8_MMA(1, 0, At, B0); PG8_BAR; PG8_SCHED;
            PG8_STAGE(PG8_SB(0, 1), b2 + hstep, voffB);
            PG8_WAIT_V(6); PG8_BAR; PG8_MMA(1, 1, At, B1); PG8_BAR;
            PG8_LDB(B0, 1, 0); PG8_SCHED; PG8_LDA(At, 1, 0); PG8_STAGE(PG8_SA(0, 1), a2 + hstep, voffA);
            PG8_WAIT_L(8); PG8_BAR; PG8_WAIT_L(0); PG8_MMA(0, 0, At, B0); PG8_BAR; PG8_SCHED;
            PG8_LDB(B1, 1, 1); PG8_STAGE(PG8_SB(1, 0), b3, voffB);
            PG8_BAR; PG8_WAIT_L(0); PG8_MMA(0, 1, At, B1); PG8_BAR;
            PG8_LDA(At, 1, 1); PG8_STAGE(PG8_SA(1, 0), a3, voffA);
            PG8_BAR; PG8_WAIT_L(0); PG8_MMA(1, 0, At, B0); PG8_BAR; PG8_SCHED;
            PG8_STAGE(PG8_SB(1, 1), b3 + hstep, voffB);
            PG8_WAIT_V(6); PG8_BAR; PG8_MMA(1, 1, At, B1); PG8_BAR;
            }
        }
        if constexpr (ALIGN_EPI) { if (wr == 0) PG8_BAR; }
        if constexpr (!Epi::AFTER_DRAIN) { int l2_; asm volatile("v_mbcnt_lo_u32_b32 %0, -1, 0\n\tv_mbcnt_hi_u32_b32 %0, -1, %0" : "=v"(l2_));
            E(acc, cur, wr, wc, l2_ & 15, l2_ >> 4); S.done(cur); }
        if (!has_next) break;
#pragma unroll
        for (int a = 0; a < 2; ++a)
#pragma unroll
            for (int b = 0; b < 2; ++b)
#pragma unroll
                for (int m = 0; m < 4; ++m)
#pragma unroll
                    for (int n = 0; n < 2; ++n) acc[a][b][m][n] = (f32x4){0.f, 0.f, 0.f, 0.f};
        cur = nxt; cA = nA; cB = nB; ++ui;
        if constexpr (ALIGN_EPI) { if (wr == 1) PG8_BAR; }
    }
    PG8_WAIT_V(0);
    if constexpr (!ALIGN_EPI) { if (wr == 0) PG8_BAR; }
    PG8_BAR;
    if constexpr (Epi::AFTER_DRAIN) { E.fused(acc, cur, wr, wc, fr, fq, lds, wid, lane); S.done(cur); }
#undef PG8_SA
#undef PG8_SB
#undef PG8_STAGE
#undef PG8_LDA
#undef PG8_LDB
#undef PG8_MMA
#undef PG8_WAIT_V
#undef PG8_WAIT_L
#undef PG8_BAR
#undef PG8_SCHED
}
}

#ifndef REP_GP
#define REP_GP 1
#endif
#ifndef REP_G1
#define REP_G1 1
#endif
#ifndef REP_MIX
#define REP_MIX 1
#endif
#ifndef REP_G2
#define REP_G2 1
#endif
#ifndef REP_G3
#define REP_G3 1
#endif
#ifndef REP_PRO
#define REP_PRO 1
#endif
#define LAS __attribute__((address_space(3)))
typedef unsigned short bf16;
typedef float f32x4 __attribute__((ext_vector_type(4)));
typedef unsigned u32x4 __attribute__((ext_vector_type(4)));
typedef unsigned u32x2 __attribute__((ext_vector_type(2)));
typedef short bf16x8 __attribute__((ext_vector_type(8)));
typedef short s16x4 __attribute__((ext_vector_type(4)));
constexpr int NWAVES = 8, NTHREADS = 512;
constexpr int BATCH = 8, SEQ = 8192, D = 1024, M = BATCH * SEQ, DEPTH = 2, PW = 3584, PLE = 256;
constexpr size_t MiB = 1u << 20;
constexpr size_t WS_CTL = 0, WS_WIN = 2 * MiB, WS_WOUT = 16 * MiB, WS_WG = 20 * MiB, WS_WP = 24 * MiB, WS_WM = 26 * MiB, WS_SSQA = 27 * MiB, WS_SSQB = 31 * MiB;
constexpr size_t WS_XB0 = 64 * MiB, WS_XB1 = 192 * MiB, WS_PB = 320 * MiB, WS_PP = 384 * MiB, WS_PROJ = 512 * MiB, WS_MIX = 640 * MiB, WS_HX = 768 * MiB, WS_END = 960 * MiB;
constexpr int RING_BYTES = 131072, LDS_BYTES = 147456;

using pg8::cvt_pk_bf16; using pg8::bf_lo; using pg8::bf_hi; using pg8::sigmoid_f; using pg8::shfl_xor_l;
__device__ __forceinline__ float silu_f(float z) { return z * sigmoid_f(z); }
__device__ __forceinline__ int fresh_lane() { int l; asm volatile("v_mbcnt_lo_u32_b32 %0, -1, 0\n\tv_mbcnt_hi_u32_b32 %0, -1, %0" : "=v"(l)); return l; }

#define XB_TMO      128
#define XB_XCNT(j)  (256  + 64 * (j))
#define XB_XSUB(j)  (1280 + 64 * (j))
#define XB_XGEN(j)  (2304 + 64 * (j))
#define XB_TOP      3328
#define XB_TOPGEN   3392
#define XCD_BAR_WORDS 3456
#define XB_SPIN_CAP (1u << 18)

__device__ __forceinline__ unsigned xb_ld(unsigned* p)              { return __hip_atomic_load(p, __ATOMIC_RELAXED, __HIP_MEMORY_SCOPE_AGENT); }
__device__ __forceinline__ unsigned xb_add(unsigned* p, unsigned v) { return __hip_atomic_fetch_add(p, v, __ATOMIC_RELAXED, __HIP_MEMORY_SCOPE_AGENT); }
__device__ __forceinline__ unsigned xb_xcc_id() { return (unsigned)__builtin_amdgcn_s_getreg((3 << 11) | 20) & 0xFu; }
#define XB_SPIN(cond, bar) do { unsigned _sp = 0; while (cond) { __builtin_amdgcn_s_sleep(1); \
    if ((++_sp & 255u) == 0u) { if (xb_ld(&(bar)[XB_TMO])) break; if (_sp > XB_SPIN_CAP) { atomicAdd(&(bar)[XB_TMO], 1u); break; } } } } while (0)

struct XcdBarrier {
    unsigned* bar; unsigned x;
    volatile LAS unsigned* st;
};

__device__ __forceinline__ XcdBarrier xcd_barrier_post(unsigned* bar, volatile LAS unsigned* st) {
    XcdBarrier b; b.bar = bar; b.x = xb_xcc_id(); b.st = st;
    if (threadIdx.x == 0) (void)xb_add(&bar[XB_XCNT(b.x)], 1u);
    return b;
}
__device__ __forceinline__ void xcd_barrier_complete(unsigned* bar, unsigned x, unsigned& nloc, unsigned& nx) {
    const unsigned G = gridDim.x * gridDim.y * gridDim.z;
    unsigned sum, cnt, mine, sp = 0u;
    for (;;) {
        sum = 0u; cnt = 0u; mine = 0u;
#pragma unroll
        for (unsigned j = 0; j < 16; ++j) { const unsigned c = xb_ld(&bar[XB_XCNT(j)]); sum += c; cnt += (c > 0u) ? 1u : 0u; }
        if (sum == G) { mine = xb_ld(&bar[XB_XCNT(x)]); break; }
        __builtin_amdgcn_s_sleep(1);
        if ((++sp & 255u) == 0u) { if (xb_ld(&bar[XB_TMO])) break; if (sp > XB_SPIN_CAP) { atomicAdd(&bar[XB_TMO], 1u); break; } }
    }
    nloc = mine > 0u ? mine : 1u; nx = cnt > 0u ? cnt : 1u;
}

__device__ __forceinline__ void xcd_barrier(const XcdBarrier& b) {
    asm volatile("s_waitcnt vmcnt(0)" ::: "memory");
    __syncthreads();
    if (threadIdx.x == 0) {
        unsigned* bar = b.bar;
        __builtin_amdgcn_s_waitcnt(0);
        unsigned nloc = b.st[0], nx = b.st[1];
        if (nloc == 0u) { xcd_barrier_complete(bar, b.x, nloc, nx); b.st[0] = nloc; b.st[1] = nx; }
        const unsigned old = xb_add(&bar[XB_XSUB(b.x)], 1u);
        const unsigned gen = old / nloc;
        if (old + 1u == (gen + 1u) * nloc) {
            __builtin_amdgcn_fence(__ATOMIC_RELEASE, "agent");
            asm volatile("s_waitcnt vmcnt(0)" ::: "memory");
            const unsigned og = xb_add(&bar[XB_TOP], 1u);
            const unsigned tg = og / nx;
            if (og + 1u == (tg + 1u) * nx) xb_add(&bar[XB_TOPGEN], 1u);
            else XB_SPIN(xb_ld(&bar[XB_TOPGEN]) == tg, bar);
            __builtin_amdgcn_fence(__ATOMIC_ACQUIRE, "agent");
            xb_add(&bar[XB_XGEN(b.x)], 1u);
            asm volatile("s_waitcnt vmcnt(0)" ::: "memory");
        } else {
            XB_SPIN(xb_ld(&bar[XB_XGEN(b.x)]) == gen, bar);
            __builtin_amdgcn_fence(__ATOMIC_ACQUIRE, "agent");
            asm volatile("s_waitcnt vmcnt(0)" ::: "memory");
        }
    }
    __syncthreads();
}


__device__ __forceinline__ int win_dst_row(int s) {
    if (s < 512) return 256 * (2 + (s >> 7)) + (s & 127);
    if (s < 1024) return s - 512;
    if (s < 1536) { const int q = s - 1024; return 256 * (2 + (q >> 7)) + 128 + (q & 127); }
    const int q = s - 1536, T = q >> 9, chn = q & 511, pn = 6 + (chn >> 6), cl = chn & 63;
    return 256 * pn + 128 * (T >> 1) + 32 * (cl >> 4) + 8 * ((cl >> 2) & 3) + 4 * (T & 1) + (cl & 3);
}
template <bool PERMW> __device__ __forceinline__ void transpose_item(const float* W, int K, int N, const float* gk, bf16* WT, LAS float* scr, int item, int lane) {
    const int nblk = N / 32, kb = item / nblk, nb = item % nblk, k0 = 64 * kb, n0 = 32 * nb;
#pragma unroll 8
    for (int i = 0; i < 32; ++i) { const int kk = 2 * i + (lane >> 5); const float sc = gk ? gk[k0 + kk] : 1.0f; scr[kk * 33 + (lane & 31)] = W[(size_t)(k0 + kk) * N + n0 + (lane & 31)] * sc; }
    asm volatile("s_waitcnt lgkmcnt(0)" ::: "memory");
    const int c = lane & 7;
#pragma unroll
    for (int j = 0; j < 4; ++j) { const int n = (lane >> 3) + 8 * j; const LAS float* s = scr + (8 * c) * 33 + n;
        u32x4 o; o.x = cvt_pk_bf16(s[0 * 33], s[1 * 33]); o.y = cvt_pk_bf16(s[2 * 33], s[3 * 33]); o.z = cvt_pk_bf16(s[4 * 33], s[5 * 33]); o.w = cvt_pk_bf16(s[6 * 33], s[7 * 33]);
        const int nd = PERMW ? win_dst_row(n0 + n) : (n0 + n);
        *(u32x4*)(WT + (size_t)nd * K + k0 + 8 * c) = o; }
    asm volatile("s_waitcnt lgkmcnt(0)" ::: "memory");
}

struct Args { const float* in[14]; float* out; unsigned char* ws; };

__device__ __forceinline__ void prologue(const Args& a, LAS unsigned char* lds, int G, int bid, int wave, int lane) {
    unsigned char* ws = a.ws;
    LAS float* scr = (LAS float*)(lds + wave * 16384);
    const int gw = bid * NWAVES + wave, NGW = G * NWAVES;
    constexpr int I_IN = (D / 64) * (PW / 32), I_SQ = (D / 64) * (D / 32), I_P = (PLE / 64) * (D / 32);
    constexpr int PER_L = I_IN + 2 * I_SQ + I_P;
    for (int it = gw; it < DEPTH * PER_L; it += NGW) {
        const int l = it / PER_L; int r = it % PER_L;
        if (r < I_IN) { transpose_item<true>(a.in[3] + (size_t)l * D * PW, D, PW, a.in[2] + l * D, (bf16*)(ws + WS_WIN) + (size_t)l * PW * D, scr, r, lane); continue; } r -= I_IN;
        if (r < I_SQ) { transpose_item<false>(a.in[9] + (size_t)l * D * D, D, D, nullptr, (bf16*)(ws + WS_WOUT) + (size_t)l * D * D, scr, r, lane); continue; } r -= I_SQ;
        if (r < I_SQ) { transpose_item<false>(a.in[11] + (size_t)l * D * D, D, D, a.in[10] + l * D, (bf16*)(ws + WS_WG) + (size_t)l * D * D, scr, r, lane); continue; } r -= I_SQ;
        transpose_item<false>(a.in[12] + (size_t)l * PLE * D, PLE, D, nullptr, (bf16*)(ws + WS_WP) + (size_t)l * D * PLE, scr, r, lane);
    }
    {
        const float* wsrc = a.in[6]; bf16* WMo = (bf16*)(ws + WS_WM);
        for (int e = (bid * NTHREADS + wave * 64 + lane) * 2; e < DEPTH * 4 * 128 * 128; e += G * NTHREADS * 2) {
            const int s = e & 127, t = (e >> 7) & 127;
            const float v0 = (s <= t) ? wsrc[e] : 0.f, v1 = (s + 1 <= t) ? wsrc[e + 1] : 0.f;
            *(unsigned*)(WMo + e) = cvt_pk_bf16(v0, v1);
        }
    }
    {
        const float* x = a.in[0]; bf16* XB = (bf16*)(ws + WS_XB0); float* ssq = (float*)(ws + WS_SSQA);
        for (int m0 = gw; m0 < M; m0 += 4 * NGW) {
            f32x4 v[4][4]; float s[4];
#pragma unroll
            for (int k = 0; k < 4; ++k) { const f32x4* xr = (const f32x4*)(x + (size_t)(m0 + k * NGW) * D) + lane;
#pragma unroll
                for (int j = 0; j < 4; ++j) v[k][j] = xr[64 * j]; }
#pragma unroll
            for (int k = 0; k < 4; ++k) { s[k] = 0.f;
#pragma unroll
                for (int j = 0; j < 4; ++j) s[k] += (v[k][j][0] * v[k][j][0] + v[k][j][1] * v[k][j][1]) + (v[k][j][2] * v[k][j][2] + v[k][j][3] * v[k][j][3]); }
#pragma unroll
            for (int o = 1; o < 64; o <<= 1) {
#pragma unroll
                for (int k = 0; k < 4; ++k) s[k] += shfl_xor_l(s[k], o, lane); }
#pragma unroll
            for (int k = 0; k < 4; ++k) { const int m = m0 + k * NGW; u32x2* o8 = (u32x2*)(XB + (size_t)m * D) + lane;
#pragma unroll
                for (int j = 0; j < 4; ++j) { u32x2 w; w.x = cvt_pk_bf16(v[k][j][0], v[k][j][1]); w.y = cvt_pk_bf16(v[k][j][2], v[k][j][3]); o8[64 * j] = w; }
                if (lane < 16) ssq[(size_t)m * 16 + lane] = (lane == 0) ? s[k] : 0.f; }
        }
    }
}

__device__ __forceinline__ void p_convert_tile(const float* p_tile, bf16* pb_tile, int wave, int lane) {
    const int tid = wave * 64 + lane;
    f32x4 v0[16], v1[16];
#pragma unroll
    for (int k = 0; k < 16; ++k) { v0[k] = ((const f32x4*)p_tile)[2 * (tid + k * NTHREADS)]; v1[k] = ((const f32x4*)p_tile)[2 * (tid + k * NTHREADS) + 1]; }
    asm volatile("" ::: "memory");
#pragma unroll
    for (int k = 0; k < 16; ++k) { u32x4 w; w.x = cvt_pk_bf16(v0[k][0], v0[k][1]); w.y = cvt_pk_bf16(v0[k][2], v0[k][3]); w.z = cvt_pk_bf16(v1[k][0], v1[k][1]); w.w = cvt_pk_bf16(v1[k][2], v1[k][3]);
        ((u32x4*)pb_tile)[tid + k * NTHREADS] = w; }
}

__device__ __forceinline__ void unpack8(const u32x4 w, float (&f)[8]) {
    f[0] = bf_lo(w.x); f[1] = bf_hi(w.x); f[2] = bf_lo(w.y); f[3] = bf_hi(w.y); f[4] = bf_lo(w.z); f[5] = bf_hi(w.z); f[6] = bf_lo(w.w); f[7] = bf_hi(w.w);
}

__device__ __forceinline__ void mixer_phase(LAS unsigned char* lds, const bf16* V, const bf16* GA, const float* HXL, const float* HX0, const float* HG0, bf16* MIX, const bf16* WM, const float* lng, const float* lnb,
                                            const float* bs, const float* cw, int chunk0, int wave, int lane) {
    for (int cc = 0; cc < 2; ++cc) {
        const int chunk = chunk0 + cc;
        const int row0 = chunk * 128, rb = row0 + 16 * wave;
        u32x4 vraw[16];
#pragma unroll
        for (int rr = 0; rr < 16; ++rr) vraw[rr] = *(const u32x4*)(V + (size_t)(rb + rr) * 512 + 8 * lane);
        if (wave == 0 && (chunk & 1) == 0 && (row0 & (SEQ - 1)) != 0) {
            const int pm = chunk >> 1;
            float w0[8], w1[8], w2[8];
            { float t[24]; const f32x4* cp = (const f32x4*)(cw + 24 * lane);
#pragma unroll
              for (int i = 0; i < 6; ++i) { const f32x4 q = cp[i]; t[4 * i] = q[0]; t[4 * i + 1] = q[1]; t[4 * i + 2] = q[2]; t[4 * i + 3] = q[3]; }
#pragma unroll
              for (int j = 0; j < 8; ++j) { w0[j] = t[3 * j]; w1[j] = t[3 * j + 1]; w2[j] = t[3 * j + 2]; } }
            float xm2[8], xm1[8], x0[8], x1r[8], g0[8], g1[8];
            { const float* p = HXL + ((size_t)(pm - 1) * 2) * 512 + 8 * lane; const f32x4 a = *(const f32x4*)p, b = *(const f32x4*)(p + 4), c = *(const f32x4*)(p + 512), d = *(const f32x4*)(p + 516);
#pragma unroll
              for (int j = 0; j < 4; ++j) { xm2[j] = a[j]; xm2[4 + j] = b[j]; xm1[j] = c[j]; xm1[4 + j] = d[j]; } }
            { const float* p = HX0 + ((size_t)pm * 2) * 512 + 8 * lane; const f32x4 a = *(const f32x4*)p, b = *(const f32x4*)(p + 4), c = *(const f32x4*)(p + 512), d = *(const f32x4*)(p + 516);
#pragma unroll
              for (int j = 0; j < 4; ++j) { x0[j] = a[j]; x0[4 + j] = b[j]; x1r[j] = c[j]; x1r[4 + j] = d[j]; } }
            { const float* p = HG0 + ((size_t)pm * 2) * 512 + 8 * lane; const f32x4 a = *(const f32x4*)p, b = *(const f32x4*)(p + 4), c = *(const f32x4*)(p + 512), d = *(const f32x4*)(p + 516);
#pragma unroll
              for (int j = 0; j < 4; ++j) { g0[j] = a[j]; g0[4 + j] = b[j]; g1[j] = c[j]; g1[4 + j] = d[j]; } }
            float o0[8], o1[8];
#pragma unroll
            for (int j = 0; j < 8; ++j) { o0[j] = g0[j] * (w0[j] * xm2[j] + w1[j] * xm1[j] + w2[j] * x0[j]); o1[j] = g1[j] * (w0[j] * xm1[j] + w1[j] * x0[j] + w2[j] * x1r[j]); }
            u32x4 ow; ow.x = cvt_pk_bf16(o0[0], o0[1]); ow.y = cvt_pk_bf16(o0[2], o0[3]); ow.z = cvt_pk_bf16(o0[4], o0[5]); ow.w = cvt_pk_bf16(o0[6], o0[7]);
            *(u32x4*)(MIX + (size_t)row0 * D + 512 + 8 * lane) = ow;
            ow.x = cvt_pk_bf16(o1[0], o1[1]); ow.y = cvt_pk_bf16(o1[2], o1[3]); ow.z = cvt_pk_bf16(o1[4], o1[5]); ow.w = cvt_pk_bf16(o1[6], o1[7]);
            *(u32x4*)(MIX + (size_t)(row0 + 1) * D + 512 + 8 * lane) = ow;
        }
        float g8[8], b8[8];
        { const f32x4 ga_ = *(const f32x4*)(lng + 8 * lane), gb_ = *(const f32x4*)(lng + 8 * lane + 4), ba = *(const f32x4*)(lnb + 8 * lane), bb = *(const f32x4*)(lnb + 8 * lane + 4);
#pragma unroll
          for (int j = 0; j < 4; ++j) { g8[j] = ga_[j]; g8[4 + j] = gb_[j]; b8[j] = ba[j]; b8[4 + j] = bb[j]; } }
#pragma unroll
        for (int hb = 0; hb < 2; ++hb) {
            float s[8], q[8];
#pragma unroll
            for (int r8 = 0; r8 < 8; ++r8) { float v[8]; unpack8(vraw[8 * hb + r8], v);
                s[r8] = ((v[0] + v[1]) + (v[2] + v[3])) + ((v[4] + v[5]) + (v[6] + v[7]));
                q[r8] = ((v[0] * v[0] + v[1] * v[1]) + (v[2] * v[2] + v[3] * v[3])) + ((v[4] * v[4] + v[5] * v[5]) + (v[6] * v[6] + v[7] * v[7])); }
#pragma unroll
            for (int o = 1; o < 64; o <<= 1) {
                float ts[8], tq[8];
#pragma unroll
                for (int r8 = 0; r8 < 8; ++r8) { ts[r8] = shfl_xor_l(s[r8], o, lane); tq[r8] = shfl_xor_l(q[r8], o, lane); }
#pragma unroll
                for (int r8 = 0; r8 < 8; ++r8) { s[r8] += ts[r8]; q[r8] += tq[r8]; }
            }
#pragma unroll
            for (int r8 = 0; r8 < 8; ++r8) {
                const int rr = 8 * hb + r8, r = 16 * wave + rr;
                float v[8]; unpack8(vraw[rr], v);
                const float mu = s[r8] * (1.0f / 512.0f);
                const float rstd = __builtin_amdgcn_rsqf(fmaxf(q[r8] * (1.0f / 512.0f) - mu * mu, 0.f) + 1e-6f);
#pragma unroll
                for (int j = 0; j < 8; ++j) v[j] = (v[j] - mu) * rstd * g8[j] + b8[j];
                u32x4 ow; ow.x = cvt_pk_bf16(v[0], v[1]); ow.y = cvt_pk_bf16(v[2], v[3]); ow.z = cvt_pk_bf16(v[4], v[5]); ow.w = cvt_pk_bf16(v[6], v[7]);
                *(LAS u32x4*)(lds + r * 1024 + 16 * (lane ^ (((r >> 3) & 3) << 1))) = ow;
            }
            asm volatile("" ::: "memory");
        }
        u32x4 ga[16];
#pragma unroll
        for (int rr = 0; rr < 16; ++rr) ga[rr] = *(const u32x4*)(GA + (size_t)(rb + rr) * 512 + 8 * lane);
        __syncthreads();
        {
            const int i = lane & 15, q = lane >> 4;
            const int tbase = (8 * q + (i >> 2)) * 1024 + 32 * (wave ^ q) + 8 * (i & 3);
#pragma unroll 1
            for (int h = 0; h < 4; ++h) {
                bf16x8 af[4];
#pragma unroll
                for (int ks = 0; ks < 4; ++ks) {
                    const s16x4 lo = __builtin_amdgcn_ds_read_tr16_b64_v4i16((LAS s16x4*)(lds + tbase + 256 * h + 32768 * ks));
                    const s16x4 hi = __builtin_amdgcn_ds_read_tr16_b64_v4i16((LAS s16x4*)(lds + tbase + 256 * h + 32768 * ks + 4096));
                    af[ks] = (bf16x8){lo[0], lo[1], lo[2], lo[3], hi[0], hi[1], hi[2], hi[3]};
                }
                asm volatile("s_waitcnt lgkmcnt(0)" ::: "memory");
                const bf16* wmh = WM + (size_t)h * 128 * 128;
                bf16x8 wf[8][4]; float bias[8];
#pragma unroll
                for (int tb = 0; tb < 8; ++tb) {
#pragma unroll
                    for (int ks = 0; ks < 4; ++ks) if (ks <= tb / 2) wf[tb][ks] = *(const bf16x8*)(wmh + (16 * tb + i) * 128 + 32 * ks + 8 * q);
                    bias[tb] = bs[h * 128 + 16 * tb + i];
                }
                asm volatile("" ::: "memory");
#pragma unroll
                for (int tb = 0; tb < 8; ++tb) {
                    f32x4 acc = (f32x4){0.f, 0.f, 0.f, 0.f};
                    const int t = 16 * tb + i;
#pragma unroll
                    for (int ks = 0; ks < 4; ++ks) if (ks <= tb / 2) acc = __builtin_amdgcn_mfma_f32_16x16x32_bf16(af[ks], wf[tb][ks], acc, 0, 0, 0);
                    u32x2 ow; ow.x = cvt_pk_bf16(acc[0] + bias[tb], acc[1] + bias[tb]); ow.y = cvt_pk_bf16(acc[2] + bias[tb], acc[3] + bias[tb]);
                    *(LAS u32x2*)(lds + t * 1024 + 2 * ((128 * h + 16 * wave + 4 * q) ^ (((t >> 3) & 3) << 4))) = ow;
                }
            }
        }
        __syncthreads();
#pragma unroll
        for (int hb = 0; hb < 2; ++hb) {
            u32x4 mxw[8];
#pragma unroll
            for (int r8 = 0; r8 < 8; ++r8) { const int r = 16 * wave + 8 * hb + r8; mxw[r8] = *(const LAS u32x4*)(lds + r * 1024 + 16 * (lane ^ (((r >> 3) & 3) << 1))); }
#pragma unroll
            for (int r8 = 0; r8 < 8; ++r8) {
                const int rr = 8 * hb + r8, r = 16 * wave + rr;
                float mx[8], gg[8];
                unpack8(mxw[r8], mx); unpack8(ga[rr], gg);
                u32x4 ow; ow.x = cvt_pk_bf16(gg[0] * mx[0], gg[1] * mx[1]); ow.y = cvt_pk_bf16(gg[2] * mx[2], gg[3] * mx[3]); ow.z = cvt_pk_bf16(gg[4] * mx[4], gg[5] * mx[5]); ow.w = cvt_pk_bf16(gg[6] * mx[6], gg[7] * mx[7]);
                *(u32x4*)(MIX + (size_t)(row0 + r) * D + 8 * lane) = ow;
            }
        }
        __syncthreads();
    }
}

__device__ __forceinline__ void final_phase(const bf16* XB, const float* ssq, const float* g, float* out, int row_base, int wave, int lane) {
    f32x4 gv[4];
#pragma unroll
    for (int j = 0; j < 2; ++j) { gv[2 * j] = *(const f32x4*)(g + 512 * j + 8 * lane); gv[2 * j + 1] = *(const f32x4*)(g + 512 * j + 8 * lane + 4); }
    for (int m0 = row_base + wave * 32; m0 < row_base + wave * 32 + 32; m0 += 4) {
        float s[4]; u32x4 w[4][2];
#pragma unroll
        for (int k = 0; k < 4; ++k) { const int m = m0 + k; s[k] = ssq[(size_t)m * 16 + (lane & 15)];
            w[k][0] = *(const u32x4*)(XB + (size_t)m * D + 8 * lane); w[k][1] = *(const u32x4*)(XB + (size_t)m * D + 512 + 8 * lane); }
#pragma unroll
        for (int o = 1; o < 16; o <<= 1) { float ts[4];
#pragma unroll
            for (int k = 0; k < 4; ++k) ts[k] = shfl_xor_l(s[k], o, lane);
#pragma unroll
            for (int k = 0; k < 4; ++k) s[k] += ts[k]; }
#pragma unroll
        for (int k = 0; k < 4; ++k) {
            const int m = m0 + k;
            const float rs = __builtin_amdgcn_rsqf(s[k] * (1.0f / 1024.0f) + 1e-6f);
#pragma unroll
            for (int j = 0; j < 2; ++j) {
                const u32x4 q = w[k][j];
                const f32x4 a = (f32x4){bf_lo(q.x), bf_hi(q.x), bf_lo(q.y), bf_hi(q.y)}, b = (f32x4){bf_lo(q.z), bf_hi(q.z), bf_lo(q.w), bf_hi(q.w)};
                float* o = out + (size_t)m * D + 512 * j + 8 * lane;
                *(f32x4*)o = a * rs * gv[2 * j]; *(f32x4*)(o + 4) = b * rs * gv[2 * j + 1];
            }
        }
    }
}

__device__ __forceinline__ unsigned char* opaque_ptr(unsigned char* p) { __attribute__((address_space(1))) unsigned char* g = (__attribute__((address_space(1))) unsigned char*)p; asm volatile("" : "+s"(g)); return (unsigned char*)g; }
__device__ __forceinline__ int opaque_int(int v) { asm volatile("" : "+s"(v)); return v; }
__device__ __forceinline__ void group_wait(unsigned* cnt, unsigned target) {
    unsigned sp = 0;
    while (__hip_atomic_load(cnt, __ATOMIC_RELAXED, __HIP_MEMORY_SCOPE_AGENT) < target) { __builtin_amdgcn_s_sleep(1); if (++sp > (1u << 24)) break; }
}
__device__ __forceinline__ void group_barrier(unsigned* cnt, unsigned target, int same_xcc, unsigned* cnt2 = nullptr, unsigned target2 = 0u) {
    asm volatile("s_waitcnt vmcnt(0)" ::: "memory");
    __syncthreads();
    if (threadIdx.x == 0) {
        if (!same_xcc) { __builtin_amdgcn_fence(__ATOMIC_RELEASE, "agent"); asm volatile("s_waitcnt vmcnt(0)" ::: "memory"); }
        (void)__hip_atomic_fetch_add(cnt, 1u, __ATOMIC_RELAXED, __HIP_MEMORY_SCOPE_AGENT);
        group_wait(cnt, target);
        if (cnt2) group_wait(cnt2, target2);
        __builtin_amdgcn_fence(__ATOMIC_ACQUIRE, "agent");
        asm volatile("s_waitcnt vmcnt(0)" ::: "memory");
    }
    __syncthreads();
}
__device__ __forceinline__ void rstd_cache(LAS float* RS, const float* ssq, int c, int wave, int lane, LAS float* CWL = nullptr, const float* cw = nullptr) {
    const int tid = wave * 64 + lane;
    if (CWL && tid < 384) *(LAS f32x4*)(CWL + 4 * tid) = *(const f32x4*)(cw + 4 * tid);
#pragma unroll
    for (int k = 0; k < 2; ++k) {
        const int idx = tid + 512 * k, g = idx >> 8, r = idx & 255, pm = ((c & 7) * 4 + g) * 8 + ((c >> 3) & 7);
        const f32x4* p = (const f32x4*)(ssq + ((size_t)pm * 256 + r) * 16);
        const f32x4 a = p[0], b = p[1], cc = p[2], d = p[3];
        const float s = (((a[0] + a[1]) + (a[2] + a[3])) + ((b[0] + b[1]) + (b[2] + b[3]))) + (((cc[0] + cc[1]) + (cc[2] + cc[3])) + ((d[0] + d[1]) + (d[2] + d[3])));
        RS[idx] = __builtin_amdgcn_rsqf(s * (1.0f / 1024.0f) + 1e-6f);
    }
    __syncthreads();
}
#define XCD_BAR() do { XcdBarrier b2_ = bar; b2_.bar = (unsigned*)opaque_ptr((unsigned char*)bar.bar); b2_.x = (unsigned)opaque_int((int)bar.x); xcd_barrier(b2_); } while (0)
__global__ void __launch_bounds__(NTHREADS, 2) fwd_megakernel(Args a) {
    extern __shared__ __attribute__((aligned(16))) unsigned char lds_raw[];
    LAS unsigned char* lds = (LAS unsigned char*)lds_raw;
    cg::grid_group grid = cg::this_grid();
    const int wave = __builtin_amdgcn_readfirstlane(threadIdx.x >> 6);
    const int G = gridDim.x, bid = blockIdx.x;
    volatile LAS unsigned* MISC = (volatile LAS unsigned*)(lds + RING_BYTES + 512);
    if (threadIdx.x < 16) MISC[threadIdx.x] = 0u;
    __syncthreads();

#pragma unroll 1
    for (int rep = 0; rep < REP_PRO; ++rep)
    prologue(a, lds, G, bid, wave, fresh_lane());
    const XcdBarrier bar = xcd_barrier_post((unsigned*)(a.ws + WS_CTL), MISC + 8);
    if (threadIdx.x == 0) __hip_atomic_store((unsigned*)(a.ws + WS_CTL + 32768) + bid, bar.x + 1u, __ATOMIC_RELAXED, __HIP_MEMORY_SCOPE_AGENT);
    if (G > 100000) grid.sync();
    XCD_BAR();
    const int grp = bid & 63, tile_j = (bid >> 3) & 7, tile_k = bid >> 6, my_tile = ((bid & 7) * 4 + tile_k) * 8 + tile_j;
    const int halo_grp = tile_j > 0 ? grp - 8 : (tile_k > 0 ? (bid & 7) + 56 : -1);
    unsigned nbar = 0u;
    int same_xcc;
    { const unsigned* xt = (const unsigned*)(a.ws + WS_CTL + 32768); const unsigned mine = bar.x + 1u; unsigned ok = 1u;
#pragma unroll
      for (int k = 0; k < 4; ++k) { ok &= (__hip_atomic_load(xt + grp + 64 * k, __ATOMIC_RELAXED, __HIP_MEMORY_SCOPE_AGENT) == mine) ? 1u : 0u;
          if (halo_grp >= 0) ok &= (__hip_atomic_load(xt + halo_grp + 64 * k, __ATOMIC_RELAXED, __HIP_MEMORY_SCOPE_AGENT) == mine) ? 1u : 0u; }
      same_xcc = __builtin_amdgcn_readfirstlane((int)ok); }
#define GROUP_BAR() do { unsigned* gc_ = (unsigned*)opaque_ptr(a.ws + WS_CTL + 16384); ++nbar; group_barrier(gc_ + 64 * grp, 4u * nbar, same_xcc); } while (0)
#pragma unroll 1
    for (int l = 0; l < DEPTH; ++l) {
#pragma unroll 1
        for (int rep = 0; rep < REP_G1; ++rep)
        {
            unsigned char* ws = opaque_ptr(a.ws);
            rstd_cache((LAS float*)(lds + RING_BYTES + 1024), (const float*)(ws + WS_SSQA), bid, wave, fresh_lane(), (LAS float*)(lds + RING_BYTES + 7168), a.in[8] + l * 512 * 3);
            pg8::Gemm g{(const bf16*)(ws + WS_XB0), (const bf16*)(ws + WS_WIN) + (size_t)l * PW * D, M, PW, D}; pg8::StaticOrder S; S.init(M, PW, G, opaque_int(bid));
            bf16* VV = (bf16*)(ws + WS_PROJ); float* HX = (float*)(ws + WS_HX) + (size_t)l * (3 * 256 * 2 * 512);
            pg8::EpiProj E{VV, VV + (size_t)M * 512, (bf16*)(ws + WS_MIX), (const LAS float*)(lds + RING_BYTES + 1024), (const LAS float*)(lds + RING_BYTES + 7168), (LAS float*)(lds + RING_BYTES + 5120), HX, HX + 256 * 2 * 512, HX + 2 * 256 * 2 * 512};
            pg8::gemm_phase<pg8::EpiProj, pg8::StaticOrder, true, true>(lds, g, S, E, opaque_int(wave));
        }
#if defined(PROBE_G1NULL)
        {
            unsigned char* ws = opaque_ptr(a.ws);
            pg8::Gemm g{(const bf16*)(ws + WS_XB0), (const bf16*)(ws + WS_WIN) + (size_t)l * PW * D, M, PW, D}; pg8::StaticOrder S; S.init(M, PW, G, opaque_int(bid));
            pg8::EpiNull E{(float*)(ws + WS_SSQB)};
            pg8::gemm_phase<pg8::EpiNull, pg8::StaticOrder, true, true>(lds, g, S, E, opaque_int(wave));
        }
#endif
#if defined(PROBE_G2NULL)
        {
            unsigned char* ws = opaque_ptr(a.ws);
            pg8::Gemm g{(const bf16*)(ws + WS_XB0), (const bf16*)(ws + WS_WG) + (size_t)l * D * D, M, D, D}; pg8::StaticOrder S; S.init(M, D, G, opaque_int(bid));
            pg8::EpiNull E{(float*)(ws + WS_SSQB)};
            pg8::gemm_phase<pg8::EpiNull, pg8::StaticOrder, true, true>(lds, g, S, E, opaque_int(wave));
        }
#endif
        { unsigned* gc_ = (unsigned*)opaque_ptr(a.ws + WS_CTL + 16384); ++nbar;
          group_barrier(gc_ + 64 * grp, 4u * nbar, same_xcc, halo_grp >= 0 ? gc_ + 64 * halo_grp : nullptr, 4u * (4u * (unsigned)l + 1u)); }
#pragma unroll 1
        for (int rep = 0; rep < REP_MIX; ++rep)
        {
            unsigned char* ws = opaque_ptr(a.ws);
            const bf16* VV = (const bf16*)(ws + WS_PROJ); const float* HX = (const float*)(ws + WS_HX) + (size_t)l * (3 * 256 * 2 * 512);
            mixer_phase(lds, VV, VV + (size_t)M * 512, HX, HX + 256 * 2 * 512, HX + 2 * 256 * 2 * 512, (bf16*)(ws + WS_MIX),
                        (const bf16*)(ws + WS_WM) + (size_t)l * 4 * 128 * 128, a.in[4] + l * 512, a.in[5] + l * 512, a.in[7] + l * 512, a.in[8] + l * 512 * 3, 2 * my_tile, wave, fresh_lane());
            p_convert_tile(a.in[1] + ((size_t)l * M + (size_t)my_tile * 256) * PLE, (bf16*)(ws + WS_PB) + ((size_t)l * M + (size_t)my_tile * 256) * PLE, wave, fresh_lane());
        }
        GROUP_BAR();
        {
            const int par = (bid >> 3) & 1;
#pragma unroll 1
            for (int step = 0; step < 2; ++step) {
                if ((step ^ par) == 0) {
#pragma unroll 1
                for (int rep = 0; rep < REP_G2; ++rep)
                {
                    unsigned char* ws = opaque_ptr(a.ws);
                    pg8::Gemm g{(const bf16*)(ws + WS_MIX), (const bf16*)(ws + WS_WOUT) + (size_t)l * D * D, M, D, D}; pg8::StaticOrder S; S.init(M, D, G, opaque_int(bid));
                    pg8::EpiResid<false> E{nullptr, (const bf16*)(ws + WS_XB0), (bf16*)(ws + WS_XB1), (float*)(ws + WS_SSQB)};
                    pg8::gemm_phase<pg8::EpiResid<false>, pg8::StaticOrder, true, true>(lds, g, S, E, opaque_int(wave));
                }
                } else {
#pragma unroll 1
                for (int rep = 0; rep < REP_GP; ++rep)
                {
                    unsigned char* ws = opaque_ptr(a.ws);
                    pg8::Gemm g{(const bf16*)(ws + WS_PB) + (size_t)l * M * PLE, (const bf16*)(ws + WS_WP) + (size_t)l * D * PLE, M, D, PLE}; pg8::StaticOrder S; S.init(M, D, G, opaque_int(bid));
                    pg8::EpiPlainBf16 E{(bf16*)(ws + WS_PP), D};
                    pg8::gemm_phase<pg8::EpiPlainBf16, pg8::StaticOrder, true, true>(lds, g, S, E, opaque_int(wave));
                }
                }
            }
        }
        GROUP_BAR();
#pragma unroll 1
        for (int rep = 0; rep < REP_G3; ++rep)
        {
            unsigned char* ws = opaque_ptr(a.ws);
            pg8::Gemm g{(const bf16*)(ws + WS_XB1), (const bf16*)(ws + WS_WG) + (size_t)l * D * D, M, D, D, 1};     pg8::StaticOrder S; S.init(M, D, G, opaque_int(bid));
            rstd_cache((LAS float*)(lds + RING_BYTES + 1024), (const float*)(ws + WS_SSQB), bid, wave, fresh_lane());
            pg8::EpiGate E{(const bf16*)(ws + WS_XB1), (const bf16*)(ws + WS_PP), (bf16*)(ws + WS_XB0), (const LAS float*)(lds + RING_BYTES + 1024), (float*)(ws + WS_SSQA)};
            pg8::gemm_phase<pg8::EpiGate, pg8::StaticOrder, true, true>(lds, g, S, E, opaque_int(wave));
        }
        GROUP_BAR();
    }
    final_phase((const bf16*)(a.ws + WS_XB0), (const float*)(a.ws + WS_SSQA), a.in[13], a.out, my_tile * 256, wave, fresh_lane());
}

extern "C" void kernel_launch(void* const* d_in, const int* in_sizes, int n_in, void* d_out, int out_size, void* d_ws, size_t ws_size, hipStream_t stream) {
    static int grid = 0;
    if (grid == 0) {
        if (n_in != 14 || out_size != M * D || ws_size < WS_END) { fprintf(stderr, "kernel_launch: unexpected shapes: n_in %d out %d ws %zu\n", n_in, out_size, ws_size); grid = -1; return; }
        int dev = 0, cus = 0, per_cu = 0;
        hipGetDevice(&dev); hipDeviceGetAttribute(&cus, hipDeviceAttributeMultiprocessorCount, dev);
        hipFuncSetAttribute((const void*)fwd_megakernel, hipFuncAttributeMaxDynamicSharedMemorySize, LDS_BYTES);
        hipOccupancyMaxActiveBlocksPerMultiprocessor(&per_cu, (const void*)fwd_megakernel, NTHREADS, LDS_BYTES);
        (void)hipGetLastError();
        if (per_cu < 1) per_cu = 1;
        grid = 256;
        fprintf(stderr, "kernel_launch: cus %d per_cu %d grid %d\n", cus, per_cu, grid);
    }
    if (grid < 0) return;
    (void)hipMemsetAsync((char*)d_ws + WS_CTL, 0, 32768 + 1024, stream);
    Args a{};
    for (int i = 0; i < 14; ++i) a.in[i] = (const float*)d_in[i];
    a.out = (float*)d_out; a.ws = (unsigned char*)d_ws;
    void* args[] = {&a};
    hipError_t e = hipLaunchCooperativeKernel((const void*)fwd_megakernel, dim3(grid), dim3(NTHREADS), args, LDS_BYTES, stream);
    if (e != hipSuccess) fprintf(stderr, "cooperative launch failed: %s (grid %d)\n", hipGetErrorString(e), grid);
}
```
